# Optimizing an MI355X kernel written in HIP

```python
import jax, jax.numpy as jnp
from jax import lax
import numpy as np

D_MODEL = 1024
BATCH = 8
SEQ = 2048
DEPTH = 4

EXPAND = 2
D_MIX = EXPAND * D_MODEL
D_FOURIER = D_MIX // 2
D_GLA = D_MIX - D_FOURIER
N_FOURIER_GROUPS = 4
FOURIER_GROUP = D_FOURIER // N_FOURIER_GROUPS
N_GLA_HEADS = 4
D_GLA_KEY = D_GLA // 2
GLA_HEAD_K = D_GLA_KEY // N_GLA_HEADS
GLA_HEAD_V = D_GLA // N_GLA_HEADS
GATE_RANK = 16
GATE_LOGIT_NORMALIZER = 16.0
CHUNK = 64
EPS = 1e-6
SPLIT_SIZES = (D_FOURIER, D_FOURIER, D_GLA_KEY, D_GLA_KEY, D_GLA, D_GLA, GATE_RANK, GATE_RANK)
D_IN_PROJ = D_FOURIER * 2 + D_GLA_KEY * 2 + D_GLA * 2 + GATE_RANK * 2

kernel_name = "hymba_fnet_bigla_adaln_encoder"


def _split_points():
    pts, acc = [], 0
    for s in SPLIT_SIZES[:-1]:
        acc += s
        pts.append(acc)
    return pts


def rmsnorm(x, g):
    xf = x.astype(jnp.float32)
    y = xf * lax.rsqrt(jnp.mean(xf * xf, axis=-1, keepdims=True) + EPS) * g.astype(jnp.float32)
    return y.astype(x.dtype)


def fourier_mix(u, w_map):
    b, l, _ = u.shape
    ug = u.reshape(b, l, N_FOURIER_GROUPS, FOURIER_GROUP).astype(jnp.float32)
    spec = jnp.fft.fft2(ug, axes=(1, 3), norm="ortho").real
    y = jnp.einsum("blgc,gcd->blgd", spec, w_map.astype(jnp.float32))
    return y.reshape(b, l, D_FOURIER).astype(u.dtype)


def gla_direction(q, k, v, log_a, strict):
    b, h, l, dk = q.shape
    dv = v.shape[-1]
    n = l // CHUNK

    def chunks(t):
        return t.reshape(b, h, n, CHUNK, t.shape[-1])

    q, k, v, log_a = chunks(q), chunks(k), chunks(v), chunks(log_a)
    cum = jnp.cumsum(log_a, axis=3)
    ref = cum[:, :, :, CHUNK // 2:CHUNK // 2 + 1]
    last = cum[:, :, :, -1:]
    qi = q * jnp.exp(cum - ref)
    ki = k * jnp.exp(ref - cum)
    scores = jnp.einsum("bhncd,bhnsd->bhncs", qi, ki)
    mask = jnp.tril(jnp.ones((CHUNK, CHUNK), dtype=bool), k=-1 if strict else 0)
    scores = jnp.where(mask, scores, 0.0)
    o_intra = jnp.einsum("bhncs,bhnsv->bhncv", scores, v)
    q_dec = q * jnp.exp(cum)
    k_dec = k * jnp.exp(last - cum)
    chunk_decay = jnp.exp(last[:, :, :, 0, :])

    def step(state, inp):
        qd, kd, vc, dec = inp
        o = jnp.einsum("bhcd,bhdv->bhcv", qd, state)
        state = dec[..., None] * state + jnp.einsum("bhcd,bhcv->bhdv", kd, vc)
        return state, o

    xs = (jnp.moveaxis(q_dec, 2, 0), jnp.moveaxis(k_dec, 2, 0),
          jnp.moveaxis(v, 2, 0), jnp.moveaxis(chunk_decay, 2, 0))
    s0 = jnp.zeros((b, h, dk, dv), jnp.float32)
    _, o_inter = lax.scan(step, s0, xs)
    o_inter = jnp.moveaxis(o_inter, 0, 2)
    return (o_intra + o_inter).reshape(b, h, l, dv)


def gla_mix(q, k, v, gf_low, gb_low, w_af, b_af, w_ab, b_ab, norm_g):
    b, l, _ = q.shape

    def heads(t, d):
        return t.astype(jnp.float32).reshape(b, l, N_GLA_HEADS, d).transpose(0, 2, 1, 3)

    qh = heads(q, GLA_HEAD_K) * (GLA_HEAD_K ** -0.5)
    kh = heads(k, GLA_HEAD_K)
    vh = heads(v, GLA_HEAD_V)
    log_af = jax.nn.log_sigmoid(gf_low.astype(jnp.float32) @ w_af.astype(jnp.float32)
                                + b_af.astype(jnp.float32)) / GATE_LOGIT_NORMALIZER
    log_ab = jax.nn.log_sigmoid(gb_low.astype(jnp.float32) @ w_ab.astype(jnp.float32)
                                + b_ab.astype(jnp.float32)) / GATE_LOGIT_NORMALIZER
    o_fwd = gla_direction(qh, kh, vh, heads(log_af, GLA_HEAD_K), strict=False)
    flip = lambda t: jnp.flip(t, axis=2)
    o_bwd = flip(gla_direction(flip(qh), flip(kh), flip(vh),
                               flip(heads(log_ab, GLA_HEAD_K)), strict=True))
    o = o_fwd + o_bwd
    o = o * lax.rsqrt(jnp.mean(o * o, axis=-1, keepdims=True) + EPS)
    o = o.transpose(0, 2, 1, 3).reshape(b, l, D_GLA) * norm_g.astype(jnp.float32)
    return o.astype(q.dtype)


def setup_inputs(seed: int = 0) -> dict:
    key = jax.random.key(seed)
    ks = jax.random.split(key, 16)
    f32 = jnp.float32
    nrm = lambda k, shape, s: jax.random.normal(k, shape, f32) * s
    return {
        "x": nrm(ks[0], (BATCH, SEQ, D_MODEL), 1.0),
        "c": nrm(ks[1], (BATCH, D_MODEL), 1.0),
        "norm_g": 1.0 + nrm(ks[2], (DEPTH, D_MODEL), 0.02),
        "w_ada": nrm(ks[3], (DEPTH, D_MODEL, 3 * D_MODEL), D_MODEL ** -0.5),
        "b_ada": nrm(ks[4], (DEPTH, 3 * D_MODEL), 0.02),
        "w_in": nrm(ks[5], (DEPTH, D_MODEL, D_IN_PROJ), D_MODEL ** -0.5),
        "w_fmap": nrm(ks[6], (DEPTH, N_FOURIER_GROUPS, FOURIER_GROUP, FOURIER_GROUP), FOURIER_GROUP ** -0.5),
        "w_af": nrm(ks[7], (DEPTH, GATE_RANK, D_GLA_KEY), GATE_RANK ** -0.5),
        "b_af": nrm(ks[8], (DEPTH, D_GLA_KEY), 0.1),
        "w_ab": nrm(ks[9], (DEPTH, GATE_RANK, D_GLA_KEY), GATE_RANK ** -0.5),
        "b_ab": nrm(ks[10], (DEPTH, D_GLA_KEY), 0.1),
        "gla_norm_g": 1.0 + nrm(ks[11], (DEPTH, D_GLA), 0.02),
        "w_out": nrm(ks[12], (DEPTH, D_MIX, D_MODEL), D_MIX ** -0.5),
        "final_g": 1.0 + nrm(ks[13], (D_MODEL,), 0.02),
    }


def reference(x, c, norm_g, w_ada, b_ada, w_in, w_fmap, w_af, b_af, w_ab, b_ab,
              gla_norm_g, w_out, final_g):
    pts = _split_points()
    c_act = jax.nn.silu(c)
    for layer in range(DEPTH):
        mod = c_act @ w_ada[layer] + b_ada[layer]
        shift, scale, gate = jnp.split(mod, 3, axis=-1)
        h = rmsnorm(x, norm_g[layer]) * (1.0 + scale[:, None, :]) + shift[:, None, :]
        proj = h @ w_in[layer]
        u_f, z_f, q, k, v, r, gf_low, gb_low = jnp.split(proj, pts, axis=-1)
        y_f = fourier_mix(u_f, w_fmap[layer]) * jax.nn.silu(z_f)
        y_g = gla_mix(q, k, v, gf_low, gb_low, w_af[layer], b_af[layer],
                      w_ab[layer], b_ab[layer], gla_norm_g[layer]) * jax.nn.silu(r)
        y = jnp.concatenate([y_f, y_g], axis=-1) @ w_out[layer]
        x = x + gate[:, None, :] * y
    return rmsnorm(x, final_g)
```

```cpp
#include <hip/hip_runtime.h>
#include <cstdio>
#include <cstdint>

#ifndef MK_PER_PHASE
#define MK_PER_PHASE 0
#endif

namespace pg8 {
#define PG8_LAS __attribute__((address_space(3)))
typedef unsigned short bf16_t;
typedef short bf16x8 __attribute__((ext_vector_type(8)));
typedef float f32x4 __attribute__((ext_vector_type(4)));
typedef unsigned u32x4 __attribute__((ext_vector_type(4)));
typedef unsigned u32x2 __attribute__((ext_vector_type(2)));
constexpr int BM = 256, BK = 64, HALF = 128, HTB = HALF * BK * 2  , STAGE_BYTES = 8 * HTB, NXCD = 8, WGM = 8;

__host__ __device__ __forceinline__ int lds_byte(int r, int c) { const int st = (r >> 4) * 2 + (c >> 5), rr = r & 15, cc = c & 31, ob = rr * 64 + cc * 2; return st * 1024 + (ob ^ (((ob >> 9) & 1) << 5)); }
__host__ __device__ __forceinline__ void stage_rc(int b, int& R, int& C) { const int st = b / 1024, sb = b % 1024, swz = sb ^ (((sb >> 9) & 1) << 5); R = (st >> 1) * 16 + swz / 64; C = (st & 1) * 32 + (swz % 64) / 2; }
__host__ __device__ __forceinline__ int perm32(int rho) { const int n = rho >> 4, i = rho & 15; return 8 * (i >> 2) + 4 * n + (i & 3); }

struct Unit { int pm, pn, bz; };
struct Gemm { const bf16_t* A; const bf16_t* A2; const bf16_t* Bt; int K, lda, ldb, ksplit; size_t bstrideA, bstrideB; };

struct StaticOrder {
    int nM, nN, nwg, G, c;
    __host__ __device__ void init(int M, int N, int G_, int c_) { nM = M / BM; nN = N / BM; nwg = nM * nN; G = G_; c = c_; }
    __host__ __device__ bool next(int i, Unit& u) const {
        const long L = (long)i * G + c; if (L >= nwg) return false;
        int wgid = (int)L; { const int q = nwg / NXCD, r = nwg % NXCD, xcd = wgid % NXCD, off = wgid / NXCD; wgid = (xcd < r ? xcd * (q + 1) : r * (q + 1) + (xcd - r) * q) + off; }
        const int nig = WGM * nN, gid = wgid / nig, fm = gid * WGM, gsz = (nM - fm) < WGM ? (nM - fm) : WGM;
        u.pm = fm + ((wgid % nig) % gsz); u.pn = (wgid % nig) / gsz; u.bz = 0; return true;
    }
};
struct BatchOrder {
    int nM, nN, G, c;
    __host__ __device__ void init(int M, int N, int G_, int c_) { nM = M / BM; nN = N / BM; G = G_; c = c_; }
    __host__ __device__ bool next(int i, Unit& u) const {
        const int per = nM * nN; const long L = (long)i * G + c; if (L >= 8L * per) return false;
        const int bz = (int)(L % 8), t = (int)(L / 8); u.bz = bz; u.pm = t / nN; u.pn = t % nN; return true;
    }
};

__device__ __forceinline__ unsigned cvt_pk_bf16(float lo, float hi) { unsigned r; asm volatile("v_cvt_pk_bf16_f32 %0, %1, %2" : "=v"(r) : "v"(lo), "v"(hi)); return r; }

template <class Epi, class Sched, bool ALIGN_EPI>
__device__ __forceinline__ void gemm_phase(PG8_LAS unsigned char* lds, const int tid, const Gemm g, const Sched& S, const Epi& E) {
    const int wid = __builtin_amdgcn_readfirstlane(tid >> 6), lane = tid & 63, wr = wid >> 2, wc = wid & 3, fr = lane & 15, fq = lane >> 4;
    const int K = g.K, nt = K / BK, ks = g.ksplit;
    unsigned voffA[2], voffB[2];
#pragma unroll
    for (int i = 0; i < 2; ++i) { int R, C; stage_rc(tid * 16 + i * 8192, R, C); const int Rb = Epi::PERM ? ((R & ~31) + perm32(R & 31)) : R;
        voffA[i] = (unsigned)(R * g.lda + C) * 2u; voffB[i] = (unsigned)(Rb * g.ldb + C) * 2u; }
    const size_t kstep = (size_t)(BK * 2);
    const size_t hstepA = (size_t)HALF * g.lda * 2, tstepA = 2 * hstepA, hstepB = (size_t)HALF * g.ldb * 2, tstepB = 2 * hstepB;
    const unsigned ldsw = (unsigned)wid * 1024u;
    const int aoff = lds_byte(wr * 64 + fr, fq * 8), boff = lds_byte(wc * 32 + fr, fq * 8);
#define PG8_SA(b, h) (((b) * 2 + (h)) * HTB)
#define PG8_SB(b, h) ((4 + (b) * 2 + (h)) * HTB)
#define PG8_STAGE(bufoff, gbase, voff) do { _Pragma("unroll") for (int _i = 0; _i < 2; ++_i) \
        __builtin_amdgcn_global_load_lds((const unsigned*)((const char*)(gbase) + (voff)[_i]), (PG8_LAS unsigned*)(lds + (bufoff) + ldsw + _i * 8192), 16, 0, 0); } while (0)
#define PG8_LDA(dst, b, h) do { _Pragma("unroll") for (int m = 0; m < 4; ++m) _Pragma("unroll") for (int k = 0; k < 2; ++k) dst[m][k] = *(const PG8_LAS bf16x8*)(lds + PG8_SA(b, h) + aoff + m * 2048 + k * 1024); } while (0)
#define PG8_LDB(dst, b, h) do { _Pragma("unroll") for (int n = 0; n < 2; ++n) _Pragma("unroll") for (int k = 0; k < 2; ++k) dst[n][k] = *(const PG8_LAS bf16x8*)(lds + PG8_SB(b, h) + boff + n * 2048 + k * 1024); } while (0)
#define PG8_MMA(ai, bj, At, Bt) do { __builtin_amdgcn_s_setprio(1); _Pragma("unroll") for (int m = 0; m < 4; ++m) _Pragma("unroll") for (int n = 0; n < 2; ++n) _Pragma("unroll") for (int k = 0; k < 2; ++k) \
        acc[ai][bj][m][n] = __builtin_amdgcn_mfma_f32_16x16x32_bf16(Bt[n][k], At[m][k], acc[ai][bj][m][n], 0, 0, 0); __builtin_amdgcn_s_setprio(0); } while (0)
#define PG8_WAIT_V(n) asm volatile("s_waitcnt vmcnt(" #n ")" ::: "memory")
#define PG8_WAIT_L(n) asm volatile("s_waitcnt lgkmcnt(" #n ")" ::: "memory")
#define PG8_BAR __builtin_amdgcn_s_barrier()
#define PG8_SCHED __builtin_amdgcn_sched_barrier(0)
#define PG8_APT(b1, t) ((b1) + (long long)(t) * (long long)kstep + ((t) >= ks ? d2 : 0ll))
    Unit cur, nxt; int ui = 0;
    if (!S.next(0, cur)) return;
    f32x4 acc[2][2][4][2];
#pragma unroll
    for (int a = 0; a < 2; ++a)
#pragma unroll
        for (int b = 0; b < 2; ++b)
#pragma unroll
            for (int m = 0; m < 4; ++m)
#pragma unroll
                for (int n = 0; n < 2; ++n) acc[a][b][m][n] = (f32x4){0.f, 0.f, 0.f, 0.f};
    bf16x8 At[4][2], B0[2][2], B1[2][2];
    const char* cA = (const char*)g.A + (size_t)cur.bz * g.bstrideA + (size_t)cur.pm * tstepA;
    const long long d2 = g.A2 ? ((const char*)g.A2 - (const char*)g.A) - (long long)ks * (long long)kstep : 0ll;
    const char* cB = (const char*)g.Bt + (size_t)cur.bz * g.bstrideB + (size_t)cur.pn * tstepB;
    PG8_STAGE(PG8_SB(0, 0), cB, voffB); PG8_STAGE(PG8_SB(0, 1), cB + hstepB, voffB); PG8_STAGE(PG8_SA(0, 0), cA, voffA); PG8_STAGE(PG8_SA(0, 1), cA + hstepA, voffA);
    if (wr == 1) PG8_BAR;
    PG8_WAIT_V(2); PG8_BAR;
    PG8_STAGE(PG8_SB(1, 0), cB + kstep, voffB); PG8_STAGE(PG8_SA(1, 0), cA + kstep, voffA); PG8_STAGE(PG8_SB(1, 1), cB + hstepB + kstep, voffB);
    PG8_WAIT_V(6); PG8_BAR;
    for (;;) {
        const bool has_next = S.next(ui + 1, nxt);
        const char* nA = has_next ? (const char*)g.A + (size_t)nxt.bz * g.bstrideA + (size_t)nxt.pm * tstepA : cA;
        const char* nB = has_next ? (const char*)g.Bt + (size_t)nxt.bz * g.bstrideB + (size_t)nxt.pn * tstepB : cB;
        for (int t = 0; t < nt; t += 2) {
            const bool last = (t == nt - 2);
            const char* a1 = PG8_APT(cA, t + 1);
            const char* a2 = last ? nA : PG8_APT(cA, t + 2); const char* b2 = last ? nB : cB + (size_t)(t + 2) * kstep;
            const char* a3 = last ? nA + kstep : PG8_APT(cA, t + 3); const char* b3 = b2 + kstep;
            PG8_LDB(B0, 0, 0); PG8_LDB(B1, 0, 1); PG8_SCHED; PG8_LDA(At, 0, 0); PG8_STAGE(PG8_SA(1, 1), a1 + hstepA, voffA);
            PG8_WAIT_V(8); PG8_WAIT_L(0); PG8_BAR; PG8_MMA(0, 0, At, B0); PG8_MMA(0, 1, At, B1); PG8_BAR; PG8_SCHED;
            PG8_LDA(At, 0, 1); PG8_STAGE(PG8_SB(0, 0), b2, voffB); PG8_STAGE(PG8_SB(0, 1), b2 + hstepB, voffB); PG8_STAGE(PG8_SA(0, 0), a2, voffA);
            PG8_WAIT_V(8); PG8_WAIT_L(0); PG8_BAR; PG8_MMA(1, 0, At, B0); PG8_MMA(1, 1, At, B1); PG8_BAR; PG8_SCHED;
            PG8_LDB(B0, 1, 0); PG8_LDB(B1, 1, 1); PG8_SCHED; PG8_LDA(At, 1, 0); PG8_STAGE(PG8_SA(0, 1), a2 + hstepA, voffA);
            PG8_WAIT_V(8); PG8_WAIT_L(0); PG8_BAR; PG8_MMA(0, 0, At, B0); PG8_MMA(0, 1, At, B1); PG8_BAR; PG8_SCHED;
            PG8_LDA(At, 1, 1); PG8_STAGE(PG8_SB(1, 0), b3, voffB); PG8_STAGE(PG8_SB(1, 1), b3 + hstepB, voffB); PG8_STAGE(PG8_SA(1, 0), a3, voffA);
            PG8_WAIT_V(8); PG8_WAIT_L(0); PG8_BAR; PG8_MMA(1, 0, At, B0); PG8_MMA(1, 1, At, B1); PG8_BAR; PG8_SCHED;
        }
        if constexpr (ALIGN_EPI) { if (wr == 0) PG8_BAR; }
        if constexpr (!Epi::AFTER_DRAIN) { E(acc, cur, wr, wc, fr, fq); }
        if (!has_next) break;
#pragma unroll
        for (int a = 0; a < 2; ++a)
#pragma unroll
            for (int b = 0; b < 2; ++b)
#pragma unroll
                for (int m = 0; m < 4; ++m)
#pragma unroll
                    for (int n = 0; n < 2; ++n) acc[a][b][m][n] = (f32x4){0.f, 0.f, 0.f, 0.f};
        cur = nxt; cA = nA; cB = nB; ++ui;
        if constexpr (ALIGN_EPI) { if (wr == 1) PG8_BAR; }
    }
    PG8_WAIT_V(0);
    if constexpr (!ALIGN_EPI) { if (wr == 0) PG8_BAR; }
    PG8_BAR;
    if constexpr (Epi::AFTER_DRAIN) { E.fused(acc, cur, wr, wc, fr, fq, lds, wid, lane); }
#undef PG8_SA
#undef PG8_SB
#undef PG8_STAGE
#undef PG8_LDA
#undef PG8_LDB
#undef PG8_MMA
#undef PG8_WAIT_V
#undef PG8_WAIT_L
#undef PG8_BAR
#undef PG8_SCHED
#undef PG8_APT
}
}

constexpr int NWAVES = 8, NTHR = NWAVES * 64;
constexpr int D = 1024, BATCH = 8, SEQ = 2048, DEPTH = 4, MTOK = BATCH * SEQ;
constexpr int DIN = 5152;
constexpr int NPJ = 6144;
constexpr int NSW = 6176;
constexpr float EPS = 1e-6f;

constexpr size_t MiB = 1u << 20;
constexpr size_t WS_CTL = 0, CTL_ZERO_BYTES = 65536;
constexpr size_t WS_MOD = 1 * MiB;
constexpr size_t WS_GMOD = WS_MOD + 512 * 1024;
constexpr size_t WS_SWRAW = 2 * MiB;
constexpr size_t WS_SW = 3 * MiB;
constexpr size_t WS_SSQ = 4 * MiB;
constexpr size_t WS_GLOW = WS_SSQ + 512 * 1024;
constexpr size_t WS_WTG = WS_GLOW + 2 * MiB;
constexpr size_t WS_WTIN = 7 * MiB;
constexpr size_t WS_WTOUT = 55 * MiB;
constexpr size_t WS_FTAB = 71 * MiB;
constexpr size_t WS_XG = 87 * MiB;
constexpr size_t WS_AB = 119 * MiB;
constexpr size_t WS_ZF = 183 * MiB;
constexpr size_t WS_Q = 215 * MiB;
constexpr size_t WS_K = 231 * MiB;
constexpr size_t WS_V = 247 * MiB;
constexpr size_t WS_R = 279 * MiB;
constexpr size_t WS_END = 311 * MiB;
constexpr size_t WS_WC = WS_AB;
constexpr int CW_BAR = 4096;

constexpr int LDS_BYTES = 147456;
constexpr int RING_BYTES = 131072;
constexpr int MISC_OFF = RING_BYTES + 320;

#define GAS __attribute__((address_space(1)))
#define LAS __attribute__((address_space(3)))
typedef unsigned short bf16;
typedef unsigned v4u __attribute__((ext_vector_type(4)));
typedef unsigned v2u __attribute__((ext_vector_type(2)));
typedef float f32x4 __attribute__((ext_vector_type(4)));
typedef GAS unsigned gu32;
#define LDS_WAIT() asm volatile("s_waitcnt lgkmcnt(0)" ::: "memory")
__device__ __forceinline__ unsigned f2bf(float f) { unsigned u = __builtin_bit_cast(unsigned, f); return (u + 0x7fffu + ((u >> 16) & 1u)) >> 16; }
__device__ __forceinline__ unsigned pk2(float lo, float hi) { return f2bf(lo) | (f2bf(hi) << 16); }
__device__ __forceinline__ float bflo(unsigned u) { return __builtin_bit_cast(float, u << 16); }
__device__ __forceinline__ float bfhi(unsigned u) { return __builtin_bit_cast(float, u & 0xffff0000u); }
__device__ __forceinline__ float bf2f(bf16 h) { return __builtin_bit_cast(float, (unsigned)h << 16); }
__device__ __forceinline__ float silu_f(float x) { return x / (1.f + __expf(-x)); }
__device__ __forceinline__ float logsig_f(float z) { return fminf(z, 0.f) - log1pf(__expf(-fabsf(z))); }

#define XB_TMO      128
#define XB_XCNT(j)  (256  + 64 * (j))
#define XB_XSUB(j)  (1280 + 64 * (j))
#define XB_XGEN(j)  (2304 + 64 * (j))
#define XB_TOP      3328
#define XB_TOPGEN   3392
#define XCD_BAR_WORDS 3456
#define XB_SPIN_CAP (1u << 18)
__device__ __forceinline__ unsigned xb_ld(unsigned* p)              { return __hip_atomic_load(p, __ATOMIC_RELAXED, __HIP_MEMORY_SCOPE_AGENT); }
__device__ __forceinline__ unsigned xb_add(unsigned* p, unsigned v) { return __hip_atomic_fetch_add(p, v, __ATOMIC_RELAXED, __HIP_MEMORY_SCOPE_AGENT); }
__device__ __forceinline__ unsigned xb_xcc_id() { return (unsigned)__builtin_amdgcn_s_getreg((3 << 11) | 20) & 0xFu; }
#define XB_SPIN(cond, bar) do { unsigned _sp = 0; while (cond) { __builtin_amdgcn_s_sleep(1); \
    if ((++_sp & 255u) == 0u) { if (xb_ld(&(bar)[XB_TMO])) break; if (_sp > XB_SPIN_CAP) { atomicAdd(&(bar)[XB_TMO], 1u); break; } } } } while (0)
struct XcdBarrier { unsigned* bar; unsigned x; volatile LAS unsigned* st; };
__device__ __forceinline__ XcdBarrier xcd_barrier_post(unsigned* bar, volatile LAS unsigned* st) {
    XcdBarrier b; b.bar = bar; b.x = xb_xcc_id(); b.st = st;
    if (threadIdx.x == 0) (void)xb_add(&bar[XB_XCNT(b.x)], 1u);
    return b;
}
__device__ __forceinline__ void xcd_barrier_complete(unsigned* bar, unsigned x, unsigned& nloc, unsigned& nx) {
    const unsigned G = gridDim.x * gridDim.y * gridDim.z;
    unsigned sum, cnt, mine, sp = 0u;
    for (;;) {
        sum = 0u; cnt = 0u; mine = 0u;
#pragma unroll
        for (unsigned j = 0; j < 16; ++j) { const unsigned c = xb_ld(&bar[XB_XCNT(j)]); sum += c; cnt += (c > 0u) ? 1u : 0u; mine = (j == x) ? c : mine; }
        if (sum == G) break;
        __builtin_amdgcn_s_sleep(1);
        if ((++sp & 255u) == 0u) { if (xb_ld(&bar[XB_TMO])) break; if (sp > XB_SPIN_CAP) { atomicAdd(&bar[XB_TMO], 1u); break; } }
    }
    nloc = mine > 0u ? mine : 1u; nx = cnt > 0u ? cnt : 1u;
}
__device__ __forceinline__ void xcd_barrier(const XcdBarrier& b) {
    asm volatile("s_waitcnt vmcnt(0)" ::: "memory");
    __syncthreads();
    if (threadIdx.x == 0) {
        unsigned* bar = b.bar;
        __builtin_amdgcn_s_waitcnt(0);
        unsigned nloc = b.st[0], nx = b.st[1];
        if (nloc == 0u) { xcd_barrier_complete(bar, b.x, nloc, nx); b.st[0] = nloc; b.st[1] = nx; }
        const unsigned old = xb_add(&bar[XB_XSUB(b.x)], 1u);
        const unsigned gen = old / nloc;
        if (old + 1u == (gen + 1u) * nloc) {
            __builtin_amdgcn_fence(__ATOMIC_RELEASE, "agent");
            asm volatile("s_waitcnt vmcnt(0)" ::: "memory");
            const unsigned og = xb_add(&bar[XB_TOP], 1u);
            const unsigned tg = og / nx;
            if (og + 1u == (tg + 1u) * nx) xb_add(&bar[XB_TOPGEN], 1u);
            else XB_SPIN(xb_ld(&bar[XB_TOPGEN]) == tg, bar);
            __builtin_amdgcn_fence(__ATOMIC_ACQUIRE, "agent");
            xb_add(&bar[XB_XGEN(b.x)], 1u);
            asm volatile("s_waitcnt vmcnt(0)" ::: "memory");
        } else {
            XB_SPIN(xb_ld(&bar[XB_XGEN(b.x)]) == gen, bar);
            __builtin_amdgcn_fence(__ATOMIC_ACQUIRE, "agent");
            asm volatile("s_waitcnt vmcnt(0)" ::: "memory");
        }
    }
    __syncthreads();
}

struct Args { const float* in[14]; float* out; unsigned char* ws; int ph_lo, ph_hi; };
typedef const __attribute__((address_space(4))) Args* KArgs;
struct Frame {
    LAS unsigned char* lds;
    int tid, lane, wave, vcu, G;
    KArgs ka; unsigned char* ws;
    __device__ __forceinline__ const float* in(int k) const { return ka->in[k]; }
};
#define F_x F.in(0)
#define F_c F.in(1)
#define F_norm_g F.in(2)
#define F_w_ada F.in(3)
#define F_b_ada F.in(4)
#define F_w_in F.in(5)
#define F_w_fmap F.in(6)
#define F_w_af F.in(7)
#define F_b_af F.in(8)
#define F_w_ab F.in(9)
#define F_b_ab F.in(10)
#define F_gla_g F.in(11)
#define F_w_out F.in(12)
#define F_final_g F.in(13)
__device__ __forceinline__ Frame make_frame(LAS unsigned char* lds) {
    Frame F; F.lds = lds;
    int t = threadIdx.x; asm volatile("" : "+v"(t));
    KArgs ka = (KArgs)__builtin_amdgcn_kernarg_segment_ptr(); asm volatile("" : "+s"(ka));
    F.ka = ka; F.ws = ka->ws;
    F.tid = t; F.lane = t & 63; F.wave = __builtin_amdgcn_readfirstlane(t >> 6);
    F.G = gridDim.x; { const int bx = blockIdx.x; F.vcu = (F.G % 8 == 0) ? (bx % 8) * (F.G / 8) + bx / 8 : bx; }
    return F;
}

struct EpiProj {
    static constexpr bool PERM = true, AFTER_DRAIN = false;
    const float* ssq; const float* sw;
    unsigned char* ws;
    __device__ __forceinline__ void operator()(const pg8::f32x4 (&acc)[2][2][4][2], const pg8::Unit& u, int wr, int wc, int fr, int fq) const {
        const int b = u.pm >> 3, pn = u.pn;
        bf16* dst; int ldc, dcol; int mode;
        if (pn < 4) { dst = (bf16*)(ws + WS_ZF); ldc = 1024; dcol = pn * 256; mode = 1; }
        else if (pn < 6) { dst = (bf16*)(ws + WS_Q); ldc = 512; dcol = (pn - 4) * 256; mode = 2; }
        else if (pn < 8) { dst = (bf16*)(ws + WS_K); ldc = 512; dcol = (pn - 6) * 256; mode = 0; }
        else if (pn < 12) { dst = (bf16*)(ws + WS_V); ldc = 1024; dcol = (pn - 8) * 256; mode = 0; }
        else { dst = (bf16*)(ws + WS_R); ldc = 1024; dcol = (pn - 12) * 256; mode = 1; }
        const int col0 = wc * 32 + 8 * fq;
        pg8::f32x4 bv[2][2];
#pragma unroll
        for (int bj = 0; bj < 2; ++bj)
#pragma unroll
            for (int n = 0; n < 2; ++n) bv[bj][n] = *(const pg8::f32x4*)(sw + (size_t)b * NSW + 2048 + pn * 256 + col0 + bj * 128 + 4 * n);
#pragma unroll
        for (int ai = 0; ai < 2; ++ai)
#pragma unroll
            for (int m = 0; m < 4; ++m) {
                const int row = u.pm * 256 + ai * 128 + wr * 64 + m * 16 + fr;
                const pg8::f32x4 p = *(const pg8::f32x4*)(ssq + (size_t)row * 4);
                const float rs = rsqrtf(((p[0] + p[1]) + (p[2] + p[3])) * (1.f / 1024.f) + EPS);
                bf16* rowp = dst + (size_t)row * ldc + dcol + col0;
#pragma unroll
                for (int bj = 0; bj < 2; ++bj) {
                    pg8::f32x4 v0 = acc[ai][bj][m][0] * rs + bv[bj][0], v1 = acc[ai][bj][m][1] * rs + bv[bj][1];
                    if (mode == 1) {
#pragma unroll
                        for (int j = 0; j < 4; ++j) { v0[j] = silu_f(v0[j]); v1[j] = silu_f(v1[j]); }
                    } else if (mode == 2) { v0 = v0 * 0.08838834764831845f; v1 = v1 * 0.08838834764831845f; }
                    pg8::u32x4 w; w.x = pg8::cvt_pk_bf16(v0[0], v0[1]); w.y = pg8::cvt_pk_bf16(v0[2], v0[3]); w.z = pg8::cvt_pk_bf16(v1[0], v1[1]); w.w = pg8::cvt_pk_bf16(v1[2], v1[3]);
                    *(pg8::u32x4*)(rowp + bj * 128) = w;
                }
            }
    }
};
struct EpiAB {
    static constexpr bool PERM = true, AFTER_DRAIN = false;
    const float* ssq; const float* sw; bf16* abT;
    __device__ __forceinline__ void operator()(const pg8::f32x4 (&acc)[2][2][4][2], const pg8::Unit& u, int wr, int wc, int fr, int fq) const {
        const int b = u.pn >> 3, pos0 = (u.pn & 7) * 256 + wc * 32 + 8 * fq, tok0 = u.pn * 256 + wc * 32 + 8 * fq;
        pg8::f32x4 rs[2][2];
#pragma unroll
        for (int bj = 0; bj < 2; ++bj)
#pragma unroll
            for (int n = 0; n < 2; ++n)
#pragma unroll
                for (int j = 0; j < 4; ++j) {
                    const pg8::f32x4 p = *(const pg8::f32x4*)(ssq + (size_t)(tok0 + bj * 128 + 4 * n + j) * 4);
                    rs[bj][n][j] = rsqrtf(((p[0] + p[1]) + (p[2] + p[3])) * (1.f / 1024.f) + EPS);
                }
#pragma unroll
        for (int ai = 0; ai < 2; ++ai)
#pragma unroll
            for (int m = 0; m < 4; ++m) {
                const int np = u.pm * 256 + ai * 128 + wr * 64 + m * 16 + fr;
                const float bias = sw[(size_t)b * NSW + np];
                bf16* rowp = abT + ((size_t)(b * 1024 + (np & 1023)) * 4096 + (size_t)(np >> 10) * 2048 + pos0);
#pragma unroll
                for (int bj = 0; bj < 2; ++bj) {
                    const pg8::f32x4 v0 = acc[ai][bj][m][0] * rs[bj][0] + bias, v1 = acc[ai][bj][m][1] * rs[bj][1] + bias;
                    pg8::u32x4 w; w.x = pg8::cvt_pk_bf16(v0[0], v0[1]); w.y = pg8::cvt_pk_bf16(v0[2], v0[3]); w.z = pg8::cvt_pk_bf16(v1[0], v1[1]); w.w = pg8::cvt_pk_bf16(v1[2], v1[3]);
                    *(pg8::u32x4*)(rowp + bj * 128) = w;
                }
            }
    }
};
struct EpiDft {
    static constexpr bool PERM = true, AFTER_DRAIN = false;
    bf16* zf;
    __device__ __forceinline__ void operator()(const pg8::f32x4 (&acc)[2][2][4][2], const pg8::Unit& u, int wr, int wc, int fr, int fq) const {
        const int col0 = u.pn * 256 + wc * 32 + 8 * fq;
#pragma unroll
        for (int ai = 0; ai < 2; ++ai)
#pragma unroll
            for (int m = 0; m < 4; ++m) {
                const int tok = u.bz * 2048 + u.pm * 256 + ai * 128 + wr * 64 + m * 16 + fr;
                bf16* rowp = zf + (size_t)tok * 1024 + col0;
#pragma unroll
                for (int bj = 0; bj < 2; ++bj) {
                    const pg8::u32x4 z = *(const pg8::u32x4*)(rowp + bj * 128);
                    const pg8::f32x4 a0 = acc[ai][bj][m][0], a1 = acc[ai][bj][m][1];
                    pg8::u32x4 w;
                    w.x = pg8::cvt_pk_bf16(a0[0] * bflo(z.x), a0[1] * bfhi(z.x)); w.y = pg8::cvt_pk_bf16(a0[2] * bflo(z.y), a0[3] * bfhi(z.y));
                    w.z = pg8::cvt_pk_bf16(a1[0] * bflo(z.z), a1[1] * bfhi(z.z)); w.w = pg8::cvt_pk_bf16(a1[2] * bflo(z.w), a1[3] * bfhi(z.w));
                    *(pg8::u32x4*)(rowp + bj * 128) = w;
                }
            }
    }
};
struct EpiOut {
    static constexpr bool PERM = false, AFTER_DRAIN = true;
    const float* xin; float* xout; bf16* xg; float* ssq; const float* gate; const float* gmodn;
    __device__ __forceinline__ void fused(pg8::f32x4 (&acc)[2][2][4][2], const pg8::Unit& u, int wr, int wc, int fr, int fq, PG8_LAS unsigned char* lds, int wid, int lane) const {
        const int b = u.pm >> 3, col0 = u.pn * 256 + wc * 32 + 4 * fq;
        PG8_LAS float* P = (PG8_LAS float*)lds;
        pg8::f32x4 gt[2][2], gm[2][2];
#pragma unroll
        for (int bj = 0; bj < 2; ++bj)
#pragma unroll
            for (int n = 0; n < 2; ++n) {
                gt[bj][n] = *(const pg8::f32x4*)(gate + (size_t)b * 3072 + col0 + bj * 128 + n * 16);
                gm[bj][n] = gmodn ? *(const pg8::f32x4*)(gmodn + (size_t)b * 1024 + col0 + bj * 128 + n * 16) : (pg8::f32x4){0.f, 0.f, 0.f, 0.f};
            }
#pragma unroll
        for (int ai = 0; ai < 2; ++ai)
#pragma unroll
            for (int m = 0; m < 4; ++m) {
                const int rl = ai * 128 + wr * 64 + m * 16 + fr; const size_t off = (size_t)(u.pm * 256 + rl) * 1024 + col0;
                float s = 0.f;
#pragma unroll
                for (int bj = 0; bj < 2; ++bj)
#pragma unroll
                    for (int n = 0; n < 2; ++n) {
                        const pg8::f32x4 xv = *(const pg8::f32x4*)(xin + off + bj * 128 + n * 16);
                        const pg8::f32x4 o = xv + gt[bj][n] * acc[ai][bj][m][n];
                        *(pg8::f32x4*)(xout + off + bj * 128 + n * 16) = o;
                        s += (o[0] * o[0] + o[1] * o[1]) + (o[2] * o[2] + o[3] * o[3]);
                        if (gmodn) { const pg8::f32x4 h = o * gm[bj][n]; pg8::u32x2 w; w.x = pg8::cvt_pk_bf16(h[0], h[1]); w.y = pg8::cvt_pk_bf16(h[2], h[3]); *(pg8::u32x2*)(xg + off + bj * 128 + n * 16) = w; }
                    }
                s += __shfl_xor(s, 16); s += __shfl_xor(s, 32);
                if (fq == 0) P[rl * 4 + wc] = s;
            }
        asm volatile("s_waitcnt lgkmcnt(0)" ::: "memory"); __builtin_amdgcn_s_barrier(); asm volatile("" ::: "memory");
        const int t = wid * 64 + lane;
        if (t < 256) { const float s = (P[t * 4 + 0] + P[t * 4 + 1]) + (P[t * 4 + 2] + P[t * 4 + 3]); ssq[(size_t)(u.pm * 256 + t) * 4 + u.pn] = s; }
    }
};

__device__ __forceinline__ void smallm_item(const Frame& F, const float* W, int ldw, int n0, int ncols, const float* bias, float* out, int ldo, LAS float* sv, LAS float* red) {
    const int cg = F.lane & 15, kq = F.lane >> 4, w = F.wave;
    float acc[8][4];
#pragma unroll
    for (int b = 0; b < 8; ++b)
#pragma unroll
        for (int j = 0; j < 4; ++j) acc[b][j] = 0.f;
    const bool ok = (n0 + 4 * cg) < ncols;
    const float* wp = W + (size_t)(128 * w + kq) * ldw + n0 + 4 * cg;
#pragma unroll 4
    for (int s = 0; s < 32; ++s) {
        const int k = 128 * w + 4 * s + kq;
        f32x4 wv = (f32x4){0.f, 0.f, 0.f, 0.f};
        if (ok) wv = *(const f32x4*)(wp + (size_t)(4 * s) * ldw);
        const f32x4 s0 = *(const LAS f32x4*)(sv + k * 8), s1 = *(const LAS f32x4*)(sv + k * 8 + 4);
#pragma unroll
        for (int j = 0; j < 4; ++j) {
            acc[0][j] += s0[0] * wv[j]; acc[1][j] += s0[1] * wv[j]; acc[2][j] += s0[2] * wv[j]; acc[3][j] += s0[3] * wv[j];
            acc[4][j] += s1[0] * wv[j]; acc[5][j] += s1[1] * wv[j]; acc[6][j] += s1[2] * wv[j]; acc[7][j] += s1[3] * wv[j];
        }
    }
#pragma unroll
    for (int b = 0; b < 8; ++b)
#pragma unroll
        for (int j = 0; j < 4; ++j) { float v = acc[b][j]; v += __shfl_xor(v, 16); v += __shfl_xor(v, 32); acc[b][j] = v; }
    if (kq == 0) {
#pragma unroll
        for (int b = 0; b < 8; ++b) *(LAS f32x4*)(red + (w * 8 + b) * 64 + 4 * cg) = (f32x4){acc[b][0], acc[b][1], acc[b][2], acc[b][3]};
    }
    __syncthreads();
    { const int b = F.tid >> 6, c = F.tid & 63; float s = 0.f;
#pragma unroll
      for (int ww = 0; ww < 8; ++ww) s += red[(ww * 8 + b) * 64 + c];
      if (n0 + c < ncols) out[(size_t)b * ldo + n0 + c] = s + (bias ? bias[n0 + c] : 0.f); }
    __syncthreads();
}
__device__ __forceinline__ void transpose_item(const float* W, int ldw, bf16* WT, int ldo, LAS float* scr, int lane) {
#pragma unroll 8
    for (int i = 0; i < 32; ++i) { const int kk = 2 * i + (lane >> 5); scr[kk * 33 + (lane & 31)] = W[(size_t)kk * ldw + (lane & 31)]; }
    LDS_WAIT(); asm volatile("" ::: "memory");
    const int c = lane & 7;
#pragma unroll
    for (int j = 0; j < 4; ++j) { const int n = (lane >> 3) + 8 * j; const LAS float* s = scr + (8 * c) * 33 + n;
        v4u o; o.x = pk2(s[0 * 33], s[1 * 33]); o.y = pk2(s[2 * 33], s[3 * 33]); o.z = pk2(s[4 * 33], s[5 * 33]); o.w = pk2(s[6 * 33], s[7 * 33]);
        *(GAS v4u*)(WT + (size_t)n * ldo + 8 * c) = o; }
    LDS_WAIT(); asm volatile("" ::: "memory");
}

__device__ __forceinline__ void phase_p0(const Frame& F) {
    LAS float* sv = (LAS float*)F.lds;
    LAS float* red = (LAS float*)(F.lds + 32768);
    for (int e = F.tid; e < 8192; e += NTHR) { const int k = e >> 3, b = e & 7; sv[e] = silu_f(F_c[b * 1024 + k]); }
    __syncthreads();
    float* mod = (float*)(F.ws + WS_MOD);
    for (int it = F.vcu; it < 4 * 48; it += F.G) { const int l = it / 48, ch = it % 48;
        smallm_item(F, F_w_ada + (size_t)l * 1024 * 3072, 3072, ch * 64, 3072, F_b_ada + l * 3072, mod + (size_t)l * 8 * 3072, 3072, sv, red); }
    __syncthreads();
    LAS float* scr = (LAS float*)(F.lds + F.wave * 16384);
    const int gw = F.vcu * NWAVES + F.wave, NGW = F.G * NWAVES;
    constexpr int I_IN = 16 * 129, I_OUT = 32 * 32, I_L = I_IN + I_OUT;
    bf16* wtin = (bf16*)(F.ws + WS_WTIN); bf16* wtg = (bf16*)(F.ws + WS_WTG); bf16* wtout = (bf16*)(F.ws + WS_WTOUT);
    for (int it = gw; it < 4 * I_L; it += NGW) {
        const int l = it / I_L; int r = it % I_L;
        if (r < I_IN) { const int kb = r / 129, nb = r % 129; const float* W = F_w_in + (size_t)l * 1024 * DIN + (size_t)(64 * kb) * DIN + 1024 + 32 * nb;
            bf16* WT = (nb < 128) ? wtin + ((size_t)l * NPJ + 2048 + 32 * nb) * 1024 + 64 * kb : wtg + ((size_t)l * 32) * 1024 + 64 * kb;
            transpose_item(W, DIN, WT, 1024, scr, F.lane); }
        else { r -= I_IN; const int kb = r / 32, nb = r % 32; const float* W = F_w_out + (size_t)l * 2048 * 1024 + (size_t)(64 * kb) * 1024 + 32 * nb;
            transpose_item(W, 1024, wtout + ((size_t)l * 1024 + 32 * nb) * 2048 + 64 * kb, 2048, scr, F.lane); }
    }
    unsigned* ft = (unsigned*)(F.ws + WS_FTAB);
    const int gt = F.vcu * NTHR + F.tid, NGT = F.G * NTHR;
    for (int e = gt; e < 2048 * 2048; e += NGT) { const int p = e >> 11, k2 = (e & 2047) * 2;
        float v[2];
#pragma unroll
        for (int j = 0; j < 2; ++j) { const int k = k2 + j; const int idx = (p * (k & 2047)) & 2047; float sn, cs; sincospif((float)idx * (1.f / 1024.f), &sn, &cs);
            v[j] = (k < 2048 ? cs : -sn) * 0.02209708691207961f; }
        ft[e] = pk2(v[0], v[1]); }
}

__device__ __forceinline__ void phase_p1(const Frame& F) {
    const float* mod = (const float*)(F.ws + WS_MOD);
    float* gmod = (float*)(F.ws + WS_GMOD);
    const int gt = F.vcu * NTHR + F.tid, NGT = F.G * NTHR;
    for (int e = gt; e < 4 * 8 * 1024; e += NGT) { const int l = e >> 13, b = (e >> 10) & 7, k = e & 1023; gmod[e] = F_norm_g[l * 1024 + k] * (1.f + mod[((size_t)l * 8 + b) * 3072 + 1024 + k]); }
    const int gw = F.vcu * NWAVES + F.wave, NGW = F.G * NWAVES;
    bf16* xg = (bf16*)(F.ws + WS_XG); float* ssq = (float*)(F.ws + WS_SSQ);
    for (int row = gw; row < MTOK; row += NGW) { const int b = row >> 11; float s = 0.f;
#pragma unroll
        for (int j = 0; j < 4; ++j) { const int k = 4 * F.lane + 256 * j; const f32x4 xv = *(const f32x4*)(F_x + (size_t)row * 1024 + k);
            const f32x4 ng = *(const f32x4*)(F_norm_g + k); const f32x4 sc = *(const f32x4*)(mod + (size_t)b * 3072 + 1024 + k);
            s += (xv[0] * xv[0] + xv[1] * xv[1]) + (xv[2] * xv[2] + xv[3] * xv[3]);
            const f32x4 h = xv * (ng * (sc + 1.f)); v2u w; w.x = pk2(h[0], h[1]); w.y = pk2(h[2], h[3]); *(v2u*)(xg + (size_t)row * 1024 + k) = w; }
#pragma unroll
        for (int o = 1; o < 64; o <<= 1) s += __shfl_xor(s, o);
        if (F.lane == 0) *(f32x4*)(ssq + (size_t)row * 4) = (f32x4){s, 0.f, 0.f, 0.f}; }
    LAS float* sv = (LAS float*)F.lds; LAS float* red = (LAS float*)(F.lds + 32768);
    float* swraw = (float*)(F.ws + WS_SWRAW);
    int curl = -1;
    for (int it = F.vcu; it < 4 * 81; it += F.G) { const int l = it / 81, ch = it % 81;
        if (l != curl) { __syncthreads(); for (int e = F.tid; e < 8192; e += NTHR) { const int k = e >> 3, b = e & 7; sv[e] = mod[((size_t)l * 8 + b) * 3072 + k]; } __syncthreads(); curl = l; }
        smallm_item(F, F_w_in + (size_t)l * 1024 * DIN, DIN, ch * 64, DIN, nullptr, swraw + (size_t)l * 8 * DIN, DIN, sv, red); }
    __syncthreads();
    LAS float* ct = (LAS float*)F.lds;
    if (F.tid < 256) { float sn, cs; sincospif((float)F.tid * (1.f / 128.f), &sn, &cs); ct[F.tid] = cs * 0.0625f; }
    __syncthreads();
    float* wc = (float*)(F.ws + WS_WC);
    for (int e = gt; e < 4 * 4 * 2 * 256 * 256; e += NGT) { const int d = e & 255, c = (e >> 8) & 255, part = (e >> 16) & 1, lg = e >> 17;
        const float* wf = F_w_fmap + (size_t)lg * 65536 + d; float s = 0.f;
        for (int cp = 0; cp < 256; ++cp) { const int idx = (c * cp - (part ? 64 : 0)) & 255; s += ct[idx] * wf[(size_t)cp * 256]; }
        wc[e] = s; }
    __syncthreads();
}

__device__ __forceinline__ void phase_p2(const Frame& F) {
    const float* wc = (const float*)(F.ws + WS_WC);
    bf16* wtin = (bf16*)(F.ws + WS_WTIN);
    LAS float* Ls = (LAS float*)F.lds;
    LAS float* Lw = (LAS float*)(F.lds + 4096);
    const int td = F.tid & 15, tk = F.tid >> 4;
    for (int it = F.vcu; it < 4 * 2 * 4 * 4 * 16; it += F.G) {
        const int kt = it & 15, dt = (it >> 4) & 3, g = (it >> 6) & 3, part = (it >> 8) & 1, l = it >> 9;
        const float* wcb = wc + ((size_t)((l * 4 + g) * 2 + part)) * 65536 + dt * 64;
        const float* wib = F_w_in + (size_t)l * 1024 * DIN + (size_t)(kt * 64) * DIN + g * 256;
        float acc[4][2];
#pragma unroll
        for (int i = 0; i < 4; ++i) { acc[i][0] = 0.f; acc[i][1] = 0.f; }
        for (int c0 = 0; c0 < 256; c0 += 16) {
            __syncthreads();
            for (int e = F.tid; e < 1024; e += NTHR) { const int cc = e >> 6, dd = e & 63; Ls[e] = wcb[(size_t)(c0 + cc) * 256 + dd]; }
            for (int e = F.tid; e < 1024; e += NTHR) { const int kk = e >> 4, cc = e & 15; Lw[kk * 17 + cc] = wib[(size_t)kk * DIN + c0 + cc]; }
            __syncthreads();
#pragma unroll
            for (int cc = 0; cc < 16; ++cc) { const f32x4 sv = *(const LAS f32x4*)(Ls + cc * 64 + 4 * td); const float w0 = Lw[(2 * tk) * 17 + cc], w1 = Lw[(2 * tk + 1) * 17 + cc];
#pragma unroll
                for (int i = 0; i < 4; ++i) { acc[i][0] += sv[i] * w0; acc[i][1] += sv[i] * w1; } }
        }
#pragma unroll
        for (int i = 0; i < 4; ++i) { const int np = part * 1024 + g * 256 + dt * 64 + 4 * td + i;
            *(unsigned*)(wtin + ((size_t)l * NPJ + np) * 1024 + kt * 64 + 2 * tk) = pk2(acc[i][0], acc[i][1]); }
    }
    __syncthreads();
    const float* swraw = (const float*)(F.ws + WS_SWRAW); float* sw = (float*)(F.ws + WS_SW);
    const int gt = F.vcu * NTHR + F.tid, NGT = F.G * NTHR;
    for (int e = gt; e < 4 * 8 * NSW; e += NGT) { const int np = e % NSW, lb = e / NSW, l = lb >> 3; float s;
        if (np < 2048) { const int part = np >> 10, g = (np >> 8) & 3, d = np & 255; const float* wcb = wc + ((size_t)((l * 4 + g) * 2 + part)) * 65536 + d; const float* su = swraw + (size_t)lb * DIN + g * 256;
            s = 0.f; for (int c = 0; c < 256; ++c) s += su[c] * wcb[(size_t)c * 256]; }
        else if (np < NPJ) s = swraw[(size_t)lb * DIN + np - 1024];
        else s = swraw[(size_t)lb * DIN + 5120 + (np - NPJ)];
        sw[e] = s; }
}

__device__ __forceinline__ void gate_rows(const Frame& F, int l) {
    const bf16* xg = (const bf16*)(F.ws + WS_XG); const bf16* wtg = (const bf16*)(F.ws + WS_WTG) + (size_t)l * 32 * 1024;
    const float* ssq = (const float*)(F.ws + WS_SSQ); const float* sw = (const float*)(F.ws + WS_SW) + (size_t)l * 8 * NSW; float* glow = (float*)(F.ws + WS_GLOW);
    const int gw = F.vcu * NWAVES + F.wave, NGW = F.G * NWAVES;
    for (int row = gw; row < MTOK; row += NGW) {
        float xv[16];
#pragma unroll
        for (int h = 0; h < 2; ++h) { const v4u u = *(const v4u*)(xg + (size_t)row * 1024 + 8 * F.lane + 512 * h);
            xv[8 * h + 0] = bflo(u.x); xv[8 * h + 1] = bfhi(u.x); xv[8 * h + 2] = bflo(u.y); xv[8 * h + 3] = bfhi(u.y); xv[8 * h + 4] = bflo(u.z); xv[8 * h + 5] = bfhi(u.z); xv[8 * h + 6] = bflo(u.w); xv[8 * h + 7] = bfhi(u.w); }
        float mine = 0.f;
#pragma unroll 4
        for (int j = 0; j < 32; ++j) { float s = 0.f;
#pragma unroll
            for (int h = 0; h < 2; ++h) { const v4u u = *(const v4u*)(wtg + (size_t)j * 1024 + 8 * F.lane + 512 * h);
                s += xv[8 * h + 0] * bflo(u.x) + xv[8 * h + 1] * bfhi(u.x) + xv[8 * h + 2] * bflo(u.y) + xv[8 * h + 3] * bfhi(u.y) + xv[8 * h + 4] * bflo(u.z) + xv[8 * h + 5] * bfhi(u.z) + xv[8 * h + 6] * bflo(u.w) + xv[8 * h + 7] * bfhi(u.w); }
#pragma unroll
            for (int o = 1; o < 64; o <<= 1) s += __shfl_xor(s, o);
            mine = (F.lane == j) ? s : mine; }
        if (F.lane < 32) { const f32x4 p = *(const f32x4*)(ssq + (size_t)row * 4); const float rs = rsqrtf(((p[0] + p[1]) + (p[2] + p[3])) * (1.f / 1024.f) + EPS);
            glow[(size_t)row * 32 + F.lane] = mine * rs + sw[(size_t)(row >> 11) * NSW + NPJ + F.lane]; }
    }
}

__device__ __forceinline__ void gla_naive(const Frame& F, int l) {
    const bf16* Q = (const bf16*)(F.ws + WS_Q); const bf16* Kb = (const bf16*)(F.ws + WS_K); const bf16* V = (const bf16*)(F.ws + WS_V);
    const float* glow = (const float*)(F.ws + WS_GLOW);
    LAS float* aT = (LAS float*)F.lds; LAS float* kT = aT + 2048; LAS float* qT = kT + 2048;
    const int vv = F.lane & 15, dq = F.lane >> 4;
    for (int it = F.vcu; it < 8 * 4 * 2 * 2; it += F.G) {
        const int vh = it & 1, dir = (it >> 1) & 1, h = (it >> 2) & 3, b = it >> 4;
        const float* wa = (dir ? F_w_ab : F_w_af) + (size_t)l * 16 * 512 + h * 128; const float* ba = (dir ? F_b_ab : F_b_af) + l * 512 + h * 128;
        bf16* O = (bf16*)(F.ws + (dir ? WS_AB : WS_XG));
        const int vcol = h * 256 + vh * 128 + F.wave * 16 + vv;
        float st[32];
#pragma unroll
        for (int j = 0; j < 32; ++j) st[j] = 0.f;
        for (int tb = 0; tb < 128; ++tb) {
            __syncthreads();
#pragma unroll
            for (int r = 0; r < 4; ++r) { const int e = F.tid + 512 * r, tt = e >> 7, d = e & 127; const int i = tb * 16 + tt; const int tok = b * 2048 + (dir ? 2047 - i : i);
                float z = ba[d]; const float* gl = glow + (size_t)tok * 32 + dir * 16;
#pragma unroll
                for (int rr = 0; rr < 16; ++rr) z += gl[rr] * wa[rr * 512 + d];
                aT[e] = __expf(logsig_f(z) * 0.0625f); kT[e] = bf2f(Kb[(size_t)tok * 512 + h * 128 + d]); qT[e] = bf2f(Q[(size_t)tok * 512 + h * 128 + d]); }
            __syncthreads();
            for (int tt = 0; tt < 16; ++tt) { const int i = tb * 16 + tt; const int tok = b * 2048 + (dir ? 2047 - i : i);
                const float vval = bf2f(V[(size_t)tok * 1024 + vcol]); float o = 0.f;
#pragma unroll
                for (int j4 = 0; j4 < 8; ++j4) { const f32x4 a4 = *(const LAS f32x4*)(aT + tt * 128 + 32 * dq + 4 * j4), k4 = *(const LAS f32x4*)(kT + tt * 128 + 32 * dq + 4 * j4), q4 = *(const LAS f32x4*)(qT + tt * 128 + 32 * dq + 4 * j4);
#pragma unroll
                    for (int j = 0; j < 4; ++j) { const float tmp = a4[j] * st[4 * j4 + j]; const float nw = tmp + k4[j] * vval; o += q4[j] * (dir ? tmp : nw); st[4 * j4 + j] = nw; } }
                o += __shfl_xor(o, 16); o += __shfl_xor(o, 32);
                if (dq == 0) O[(size_t)tok * 1024 + vcol] = (bf16)f2bf(o); }
        }
    }
    __syncthreads();
}

__device__ __forceinline__ void gla_finalize(const Frame& F, int l) {
    const bf16* Of = (const bf16*)(F.ws + WS_XG); const bf16* Ob = (const bf16*)(F.ws + WS_AB); bf16* R = (bf16*)(F.ws + WS_R);
    const float* gg = F_gla_g + l * 1024;
    const int gw = F.vcu * NWAVES + F.wave, NGW = F.G * NWAVES;
    for (int tok = gw; tok < MTOK; tok += NGW) {
        const size_t off = (size_t)tok * 1024 + 16 * F.lane;
        float o[16]; float ss = 0.f;
#pragma unroll
        for (int h = 0; h < 2; ++h) { const v4u a = *(const v4u*)(Of + off + 8 * h), c = *(const v4u*)(Ob + off + 8 * h);
            o[8 * h + 0] = bflo(a.x) + bflo(c.x); o[8 * h + 1] = bfhi(a.x) + bfhi(c.x); o[8 * h + 2] = bflo(a.y) + bflo(c.y); o[8 * h + 3] = bfhi(a.y) + bfhi(c.y);
            o[8 * h + 4] = bflo(a.z) + bflo(c.z); o[8 * h + 5] = bfhi(a.z) + bfhi(c.z); o[8 * h + 6] = bflo(a.w) + bflo(c.w); o[8 * h + 7] = bfhi(a.w) + bfhi(c.w); }
#pragma unroll
        for (int j = 0; j < 16; ++j) ss += o[j] * o[j];
        ss += __shfl_xor(ss, 1); ss += __shfl_xor(ss, 2); ss += __shfl_xor(ss, 4); ss += __shfl_xor(ss, 8);
        const float rs = rsqrtf(ss * (1.f / 256.f) + EPS);
#pragma unroll
        for (int h = 0; h < 2; ++h) { const v4u rr = *(const v4u*)(R + off + 8 * h); const f32x4 g0 = *(const f32x4*)(gg + 16 * F.lane + 8 * h), g1 = *(const f32x4*)(gg + 16 * F.lane + 8 * h + 4);
            v4u w;
            w.x = pk2(o[8 * h + 0] * rs * g0[0] * bflo(rr.x), o[8 * h + 1] * rs * g0[1] * bfhi(rr.x)); w.y = pk2(o[8 * h + 2] * rs * g0[2] * bflo(rr.y), o[8 * h + 3] * rs * g0[3] * bfhi(rr.y));
            w.z = pk2(o[8 * h + 4] * rs * g1[0] * bflo(rr.z), o[8 * h + 5] * rs * g1[1] * bfhi(rr.z)); w.w = pk2(o[8 * h + 6] * rs * g1[2] * bflo(rr.w), o[8 * h + 7] * rs * g1[3] * bfhi(rr.w));
            *(v4u*)(R + off + 8 * h) = w; }
    }
}

__device__ __forceinline__ void final_norm(const Frame& F) {
    const float* ssq = (const float*)(F.ws + WS_SSQ);
    const int gw = F.vcu * NWAVES + F.wave, NGW = F.G * NWAVES;
    for (int row = gw; row < MTOK; row += NGW) { const f32x4 p = *(const f32x4*)(ssq + (size_t)row * 4); const float rs = rsqrtf(((p[0] + p[1]) + (p[2] + p[3])) * (1.f / 1024.f) + EPS);
#pragma unroll
        for (int j = 0; j < 4; ++j) { const int k = 4 * F.lane + 256 * j; float* p4 = F.ka->out + (size_t)row * 1024 + k; const f32x4 xv = *(const f32x4*)p4; const f32x4 g = *(const f32x4*)(F_final_g + k);
            *(f32x4*)p4 = xv * rs * g; } }
}

constexpr int N_PRO = 3, PH_PER_LAYER = 5, N_PHASES = N_PRO + DEPTH * PH_PER_LAYER + 1;

__global__ void __launch_bounds__(NTHR, 2) mk_fwd(Args args) {
    extern __shared__ __attribute__((aligned(16))) unsigned char lds[];
    LAS unsigned char* const L = (LAS unsigned char*)lds;
    volatile LAS unsigned* MISC = (volatile LAS unsigned*)(L + MISC_OFF);
    if (threadIdx.x < 32) MISC[threadIdx.x] = 0u;
    __syncthreads();
    const int lo = args.ph_lo, hi = args.ph_hi;
    XcdBarrier bar; bar.bar = (unsigned*)(args.ws + WS_CTL) + CW_BAR; bar.x = 0; bar.st = nullptr;
    if (hi - lo > 1) bar = xcd_barrier_post((unsigned*)(args.ws + WS_CTL) + CW_BAR, MISC + 8);
#define IN(k) (lo <= (k) && (k) < hi)
#define SEAM(k) do { if (IN(k) && IN((k) + 1)) xcd_barrier(bar); } while (0)

    if (IN(0)) { const Frame F = make_frame(L); phase_p0(F); } SEAM(0);
    if (IN(1)) { const Frame F = make_frame(L); phase_p1(F); } SEAM(1);
    if (IN(2)) { const Frame F = make_frame(L); phase_p2(F); } SEAM(2);

    for (int l = 0; l < DEPTH; ++l) {
        const int pb = N_PRO + l * PH_PER_LAYER;
        if (IN(pb + 0)) {
            { const Frame F = make_frame(L);
              const bf16* wtin = (const bf16*)(F.ws + WS_WTIN) + (size_t)l * NPJ * 1024; const float* sw = (const float*)(F.ws + WS_SW) + (size_t)l * 8 * NSW;
              pg8::Gemm g{wtin, nullptr, (const bf16*)(F.ws + WS_XG), 1024, 1024, 1024, 16, 0, 0};
              pg8::StaticOrder S; S.init(2048, MTOK, F.G, (int)blockIdx.x);
              EpiAB E{(const float*)(F.ws + WS_SSQ), sw, (bf16*)(F.ws + WS_AB)};
              pg8::gemm_phase<EpiAB, pg8::StaticOrder, true>(F.lds, F.tid, g, S, E); }
            { const Frame F = make_frame(L);
              const bf16* wtin = (const bf16*)(F.ws + WS_WTIN) + (size_t)l * NPJ * 1024; const float* sw = (const float*)(F.ws + WS_SW) + (size_t)l * 8 * NSW;
              pg8::Gemm g{(const bf16*)(F.ws + WS_XG), nullptr, wtin + (size_t)2048 * 1024, 1024, 1024, 1024, 16, 0, 0};
              pg8::StaticOrder S; S.init(MTOK, 4096, F.G, (int)blockIdx.x);
              EpiProj E{(const float*)(F.ws + WS_SSQ), sw, F.ws};
              pg8::gemm_phase<EpiProj, pg8::StaticOrder, true>(F.lds, F.tid, g, S, E); }
            { const Frame F = make_frame(L); gate_rows(F, l); }
        }
        SEAM(pb + 0);
        if (IN(pb + 1)) {
            const Frame F = make_frame(L);
            pg8::Gemm g{(const bf16*)(F.ws + WS_FTAB), nullptr, (const bf16*)(F.ws + WS_AB), 4096, 4096, 4096, 64, 0, (size_t)1024 * 4096 * 2};
            pg8::BatchOrder S; S.init(2048, 1024, F.G, (int)blockIdx.x);
            EpiDft E{(bf16*)(F.ws + WS_ZF)};
            pg8::gemm_phase<EpiDft, pg8::BatchOrder, true>(F.lds, F.tid, g, S, E);
        }
        SEAM(pb + 1);
        if (IN(pb + 2)) { const Frame F = make_frame(L); gla_naive(F, l); }
        SEAM(pb + 2);
        if (IN(pb + 3)) { const Frame F = make_frame(L); gla_finalize(F, l); }
        SEAM(pb + 3);
        if (IN(pb + 4)) {
            const Frame F = make_frame(L);
            const float* mod = (const float*)(F.ws + WS_MOD);
            pg8::Gemm g{(const bf16*)(F.ws + WS_ZF), (const bf16*)(F.ws + WS_R), (const bf16*)(F.ws + WS_WTOUT) + (size_t)l * 1024 * 2048, 2048, 1024, 2048, 16, 0, 0};
            pg8::StaticOrder S; S.init(MTOK, 1024, F.G, (int)blockIdx.x);
            EpiOut E{l == 0 ? F_x : (const float*)F.ka->out, F.ka->out, (bf16*)(F.ws + WS_XG), (float*)(F.ws + WS_SSQ), mod + (size_t)l * 8 * 3072 + 2048,
                     l + 1 < DEPTH ? (const float*)(F.ws + WS_GMOD) + (size_t)(l + 1) * 8 * 1024 : nullptr};
            if (F.G == 256) pg8::gemm_phase<EpiOut, pg8::StaticOrder, false>(F.lds, F.tid, g, S, E);
        }
        SEAM(pb + 4);
    }
    if (IN(N_PHASES - 1)) { const Frame F = make_frame(L); final_norm(F); }
#undef IN
#undef SEAM
}

extern "C" void kernel_launch(void* const* d_in, const int* in_sizes, int n_in, void* d_out, int out_size, void* d_ws, size_t ws_size, hipStream_t stream) {
    static int grid = 0;
    if (grid == 0) {
        if (n_in != 14 || out_size != MTOK * D || ws_size < WS_END) { fprintf(stderr, "kernel_launch: unexpected problem (n_in %d, out %d, ws %zu < %zu)\n", n_in, out_size, ws_size, (size_t)WS_END); grid = -1; return; }
        int dev = 0, cus = 0;
        if (hipGetDevice(&dev) != hipSuccess || hipDeviceGetAttribute(&cus, hipDeviceAttributeMultiprocessorCount, dev) != hipSuccess) { grid = -1; return; }
        if (hipFuncSetAttribute((const void*)mk_fwd, hipFuncAttributeMaxDynamicSharedMemorySize, LDS_BYTES) != hipSuccess) { fprintf(stderr, "kernel_launch: hipFuncSetAttribute failed\n"); grid = -1; return; }
        (void)hipGetLastError();
        grid = cus;
        if (grid != 256) fprintf(stderr, "kernel_launch: %d CUs; built for 256\n", grid);
    }
    if (grid < 0) return;
    (void)hipMemsetAsync((char*)d_ws + WS_CTL, 0, CTL_ZERO_BYTES, stream);
    Args a{};
    for (int i = 0; i < 14; ++i) a.in[i] = (const float*)d_in[i];
    a.out = (float*)d_out; a.ws = (unsigned char*)d_ws;
#if MK_PER_PHASE
    for (int p = 0; p < N_PHASES; ++p) { a.ph_lo = p; a.ph_hi = p + 1; hipLaunchKernelGGL(mk_fwd, dim3(grid), dim3(NTHR), LDS_BYTES, stream, a); }
#else
    a.ph_lo = 0; a.ph_hi = N_PHASES; hipLaunchKernelGGL(mk_fwd, dim3(grid), dim3(NTHR), LDS_BYTES, stream, a);
#endif
}
```

```cpp
#include <hip/hip_runtime.h>
#include <cstdio>
#include <cstdint>

#ifndef MK_PER_PHASE
#define MK_PER_PHASE 0
#endif

namespace pg8 {
#define PG8_LAS __attribute__((address_space(3)))
typedef unsigned short bf16_t;
typedef short bf16x8 __attribute__((ext_vector_type(8)));
typedef float f32x4 __attribute__((ext_vector_type(4)));
typedef unsigned u32x4 __attribute__((ext_vector_type(4)));
typedef unsigned u32x2 __attribute__((ext_vector_type(2)));
constexpr int BM = 256, BK = 64, HALF = 128, HTB = HALF * BK * 2  , STAGE_BYTES = 8 * HTB, NXCD = 8, WGM = 8;

__host__ __device__ __forceinline__ int lds_byte(int r, int c) { const int st = (r >> 4) * 2 + (c >> 5), rr = r & 15, cc = c & 31, ob = rr * 64 + cc * 2; return st * 1024 + (ob ^ (((ob >> 9) & 1) << 5)); }
__host__ __device__ __forceinline__ void stage_rc(int b, int& R, int& C) { const int st = b / 1024, sb = b % 1024, swz = sb ^ (((sb >> 9) & 1) << 5); R = (st >> 1) * 16 + swz / 64; C = (st & 1) * 32 + (swz % 64) / 2; }
__host__ __device__ __forceinline__ int perm32(int rho) { const int n = rho >> 4, i = rho & 15; return 8 * (i >> 2) + 4 * n + (i & 3); }

struct Unit { int pm, pn, bz; };
struct Gemm { const bf16_t* A; const bf16_t* A2; const bf16_t* Bt; int K, lda, ldb, ksplit; size_t bstrideA, bstrideB; };

struct StaticOrder {
    int nM, nN, nwg, G, c;
    __host__ __device__ void init(int M, int N, int G_, int c_) { nM = M / BM; nN = N / BM; nwg = nM * nN; G = G_; c = c_; }
    __host__ __device__ bool next(int i, Unit& u) const {
        const long L = (long)i * G + c; if (L >= nwg) return false;
        int wgid = (int)L; { const int q = nwg / NXCD, r = nwg % NXCD, xcd = wgid % NXCD, off = wgid / NXCD; wgid = (xcd < r ? xcd * (q + 1) : r * (q + 1) + (xcd - r) * q) + off; }
        const int nig = WGM * nN, gid = wgid / nig, fm = gid * WGM, gsz = (nM - fm) < WGM ? (nM - fm) : WGM;
        u.pm = fm + ((wgid % nig) % gsz); u.pn = (wgid % nig) / gsz; u.bz = 0; return true;
    }
};
struct BatchOrder {
    int nM, nN, G, c;
    __host__ __device__ void init(int M, int N, int G_, int c_) { nM = M / BM; nN = N / BM; G = G_; c = c_; }
    __host__ __device__ bool next(int i, Unit& u) const {
        const int per = nM * nN; const long L = (long)i * G + c; if (L >= 8L * per) return false;
        const int bz = (int)(L % 8), t = (int)(L / 8); u.bz = bz; u.pm = t / nN; u.pn = t % nN; return true;
    }
};

__device__ __forceinline__ unsigned cvt_pk_bf16(float lo, float hi) { unsigned r; asm volatile("v_cvt_pk_bf16_f32 %0, %1, %2" : "=v"(r) : "v"(lo), "v"(hi)); return r; }

template <class Epi, class Sched, bool ALIGN_EPI>
__device__ __forceinline__ void gemm_phase(PG8_LAS unsigned char* lds, const int tid, const Gemm g, const Sched& S, const Epi& E) {
    const int wid = __builtin_amdgcn_readfirstlane(tid >> 6), lane = tid & 63, wr = wid >> 2, wc = wid & 3, fr = lane & 15, fq = lane >> 4;
    const int K = g.K, nt = K / BK, ks = g.ksplit;
    unsigned voffA[2], voffB[2];
#pragma unroll
    for (int i = 0; i < 2; ++i) { int R, C; stage_rc(tid * 16 + i * 8192, R, C); const int Rb = Epi::PERM ? ((R & ~31) + perm32(R & 31)) : R;
        voffA[i] = (unsigned)(R * g.lda + C) * 2u; voffB[i] = (unsigned)(Rb * g.ldb + C) * 2u; }
    const size_t kstep = (size_t)(BK * 2);
    const size_t hstepA = (size_t)HALF * g.lda * 2, tstepA = 2 * hstepA, hstepB = (size_t)HALF * g.ldb * 2, tstepB = 2 * hstepB;
    const unsigned ldsw = (unsigned)wid * 1024u;
    const int aoff = lds_byte(wr * 64 + fr, fq * 8), boff = lds_byte(wc * 32 + fr, fq * 8);
#define PG8_SA(b, h) (((b) * 2 + (h)) * HTB)
#define PG8_SB(b, h) ((4 + (b) * 2 + (h)) * HTB)
#define PG8_STAGE(bufoff, gbase, voff) do { _Pragma("unroll") for (int _i = 0; _i < 2; ++_i) \
        __builtin_amdgcn_global_load_lds((const unsigned*)((const char*)(gbase) + (voff)[_i]), (PG8_LAS unsigned*)(lds + (bufoff) + ldsw + _i * 8192), 16, 0, 0); } while (0)
#define PG8_LDA(dst, b, h) do { _Pragma("unroll") for (int m = 0; m < 4; ++m) _Pragma("unroll") for (int k = 0; k < 2; ++k) dst[m][k] = *(const PG8_LAS bf16x8*)(lds + PG8_SA(b, h) + aoff + m * 2048 + k * 1024); } while (0)
#define PG8_LDB(dst, b, h) do { _Pragma("unroll") for (int n = 0; n < 2; ++n) _Pragma("unroll") for (int k = 0; k < 2; ++k) dst[n][k] = *(const PG8_LAS bf16x8*)(lds + PG8_SB(b, h) + boff + n * 2048 + k * 1024); } while (0)
#define PG8_MMA(ai, bj, At, Bt) do { __builtin_amdgcn_s_setprio(1); _Pragma("unroll") for (int m = 0; m < 4; ++m) _Pragma("unroll") for (int n = 0; n < 2; ++n) _Pragma("unroll") for (int k = 0; k < 2; ++k) \
        acc[ai][bj][m][n] = __builtin_amdgcn_mfma_f32_16x16x32_bf16(Bt[n][k], At[m][k], acc[ai][bj][m][n], 0, 0, 0); __builtin_amdgcn_s_setprio(0); } while (0)
#define PG8_WAIT_V(n) asm volatile("s_waitcnt vmcnt(" #n ")" ::: "memory")
#define PG8_WAIT_L(n) asm volatile("s_waitcnt lgkmcnt(" #n ")" ::: "memory")
#define PG8_BAR __builtin_amdgcn_s_barrier()
#define PG8_SCHED __builtin_amdgcn_sched_barrier(0)
#define PG8_APT(b1, t) ((b1) + (long long)(t) * (long long)kstep + ((t) >= ks ? d2 : 0ll))
    Unit cur, nxt; int ui = 0;
    if (!S.next(0, cur)) return;
    f32x4 acc[2][2][4][2];
#pragma unroll
    for (int a = 0; a < 2; ++a)
#pragma unroll
        for (int b = 0; b < 2; ++b)
#pragma unroll
            for (int m = 0; m < 4; ++m)
#pragma unroll
                for (int n = 0; n < 2; ++n) acc[a][b][m][n] = (f32x4){0.f, 0.f, 0.f, 0.f};
    bf16x8 At[4][2], B0[2][2], B1[2][2];
    const char* cA = (const char*)g.A + (size_t)cur.bz * g.bstrideA + (size_t)cur.pm * tstepA;
    const long long d2 = g.A2 ? ((const char*)g.A2 - (const char*)g.A) - (long long)ks * (long long)kstep : 0ll;
    const char* cB = (const char*)g.Bt + (size_t)cur.bz * g.bstrideB + (size_t)cur.pn * tstepB;
    PG8_STAGE(PG8_SB(0, 0), cB, voffB); PG8_STAGE(PG8_SB(0, 1), cB + hstepB, voffB); PG8_STAGE(PG8_SA(0, 0), cA, voffA); PG8_STAGE(PG8_SA(0, 1), cA + hstepA, voffA);
    if (wr == 1) PG8_BAR;
    PG8_WAIT_V(2); PG8_BAR;
    PG8_STAGE(PG8_SB(1, 0), cB + kstep, voffB); PG8_STAGE(PG8_SA(1, 0), cA + kstep, voffA); PG8_STAGE(PG8_SB(1, 1), cB + hstepB + kstep, voffB);
    PG8_WAIT_V(6); PG8_BAR;
    for (;;) {
        const bool has_next = S.next(ui + 1, nxt);
        const char* nA = has_next ? (const char*)g.A + (size_t)nxt.bz * g.bstrideA + (size_t)nxt.pm * tstepA : cA;
        const char* nB = has_next ? (const char*)g.Bt + (size_t)nxt.bz * g.bstrideB + (size_t)nxt.pn * tstepB : cB;
        for (int t = 0; t < nt; t += 2) {
            const bool last = (t == nt - 2);
            const char* a1 = PG8_APT(cA, t + 1);
            const char* a2 = last ? nA : PG8_APT(cA, t + 2); const char* b2 = last ? nB : cB + (size_t)(t + 2) * kstep;
            const char* a3 = last ? nA + kstep : PG8_APT(cA, t + 3); const char* b3 = b2 + kstep;
            PG8_LDB(B0, 0, 0); PG8_LDB(B1, 0, 1); PG8_SCHED; PG8_LDA(At, 0, 0); PG8_STAGE(PG8_SA(1, 1), a1 + hstepA, voffA);
            PG8_WAIT_V(8); PG8_WAIT_L(0); PG8_BAR; PG8_MMA(0, 0, At, B0); PG8_MMA(0, 1, At, B1); PG8_BAR; PG8_SCHED;
            PG8_LDA(At, 0, 1); PG8_STAGE(PG8_SB(0, 0), b2, voffB); PG8_STAGE(PG8_SB(0, 1), b2 + hstepB, voffB); PG8_STAGE(PG8_SA(0, 0), a2, voffA);
            PG8_WAIT_V(8); PG8_WAIT_L(0); PG8_BAR; PG8_MMA(1, 0, At, B0); PG8_MMA(1, 1, At, B1); PG8_BAR; PG8_SCHED;
            PG8_LDB(B0, 1, 0); PG8_LDB(B1, 1, 1); PG8_SCHED; PG8_LDA(At, 1, 0); PG8_STAGE(PG8_SA(0, 1), a2 + hstepA, voffA);
            PG8_WAIT_V(8); PG8_WAIT_L(0); PG8_BAR; PG8_MMA(0, 0, At, B0); PG8_MMA(0, 1, At, B1); PG8_BAR; PG8_SCHED;
            PG8_LDA(At, 1, 1); PG8_STAGE(PG8_SB(1, 0), b3, voffB); PG8_STAGE(PG8_SB(1, 1), b3 + hstepB, voffB); PG8_STAGE(PG8_SA(1, 0), a3, voffA);
            PG8_WAIT_V(8); PG8_WAIT_L(0); PG8_BAR; PG8_MMA(1, 0, At, B0); PG8_MMA(1, 1, At, B1); PG8_BAR; PG8_SCHED;
        }
        if constexpr (ALIGN_EPI) { if (wr == 0) PG8_BAR; }
        if constexpr (!Epi::AFTER_DRAIN) { E(acc, cur, wr, wc, fr, fq); }
        if (!has_next) break;
#pragma unroll
        for (int a = 0; a < 2; ++a)
#pragma unroll
            for (int b = 0; b < 2; ++b)
#pragma unroll
                for (int m = 0; m < 4; ++m)
#pragma unroll
                    for (int n = 0; n < 2; ++n) acc[a][b][m][n] = (f32x4){0.f, 0.f, 0.f, 0.f};
        cur = nxt; cA = nA; cB = nB; ++ui;
        if constexpr (ALIGN_EPI) { if (wr == 1) PG8_BAR; }
    }
    PG8_WAIT_V(0);
    if constexpr (!ALIGN_EPI) { if (wr == 0) PG8_BAR; }
    PG8_BAR;
    if constexpr (Epi::AFTER_DRAIN) { E.fused(acc, cur, wr, wc, fr, fq, lds, wid, lane); }
#undef PG8_SA
#undef PG8_SB
#undef PG8_STAGE
#undef PG8_LDA
#undef PG8_LDB
#undef PG8_MMA
#undef PG8_WAIT_V
#undef PG8_WAIT_L
#undef PG8_BAR
#undef PG8_SCHED
#undef PG8_APT
}
}

constexpr int NWAVES = 8, NTHR = NWAVES * 64;
constexpr int D = 1024, BATCH = 8, SEQ = 2048, DEPTH = 4, MTOK = BATCH * SEQ;
constexpr int DIN = 5152;
constexpr int NPJ = 6144;
constexpr int NSW = 6176;
constexpr float EPS = 1e-6f;

constexpr size_t MiB = 1u << 20;
constexpr size_t WS_CTL = 0, CTL_ZERO_BYTES = 65536;
constexpr size_t WS_MOD = 1 * MiB;
constexpr size_t WS_GMOD = WS_MOD + 512 * 1024;
constexpr size_t WS_SWRAW = 2 * MiB;
constexpr size_t WS_SW = 3 * MiB;
constexpr size_t WS_SSQ = 4 * MiB;
constexpr size_t WS_GLOW = WS_SSQ + 512 * 1024;
constexpr size_t WS_WTG = WS_GLOW + 2 * MiB;
constexpr size_t WS_WTIN = 7 * MiB;
constexpr size_t WS_WTOUT = 55 * MiB;
constexpr size_t WS_FTAB = 71 * MiB;
constexpr size_t WS_XG = 87 * MiB;
constexpr size_t WS_AB = 119 * MiB;
constexpr size_t WS_ZF = 183 * MiB;
constexpr size_t WS_Q = 215 * MiB;
constexpr size_t WS_K = 231 * MiB;
constexpr size_t WS_V = 247 * MiB;
constexpr size_t WS_R = 279 * MiB;
constexpr size_t WS_DEC = 311 * MiB;
constexpr size_t WS_END = 315 * MiB;
constexpr size_t WS_QIB = WS_XG, WS_KIB = WS_XG + 16 * MiB;
constexpr size_t WS_OF = WS_AB, WS_OB = WS_AB + 32 * MiB;
constexpr size_t WS_WC = WS_AB;
constexpr int CW_BAR = 4096;

constexpr int LDS_BYTES = 147456;
constexpr int RING_BYTES = 131072;
constexpr int MISC_OFF = RING_BYTES + 320;

#define GAS __attribute__((address_space(1)))
#define LAS __attribute__((address_space(3)))
typedef unsigned short bf16;
typedef unsigned v4u __attribute__((ext_vector_type(4)));
typedef unsigned v2u __attribute__((ext_vector_type(2)));
typedef float f32x4 __attribute__((ext_vector_type(4)));
typedef GAS unsigned gu32;
#define LDS_WAIT() asm volatile("s_waitcnt lgkmcnt(0)" ::: "memory")
__device__ __forceinline__ unsigned f2bf(float f) { unsigned u = __builtin_bit_cast(unsigned, f); return (u + 0x7fffu + ((u >> 16) & 1u)) >> 16; }
__device__ __forceinline__ unsigned pk2(float lo, float hi) { return f2bf(lo) | (f2bf(hi) << 16); }
__device__ __forceinline__ float bflo(unsigned u) { return __builtin_bit_cast(float, u << 16); }
__device__ __forceinline__ float bfhi(unsigned u) { return __builtin_bit_cast(float, u & 0xffff0000u); }
__device__ __forceinline__ float bf2f(bf16 h) { return __builtin_bit_cast(float, (unsigned)h << 16); }
__device__ __forceinline__ float silu_f(float x) { return x / (1.f + __expf(-x)); }
__device__ __forceinline__ float logsig_f(float z) { return fminf(z, 0.f) - log1pf(__expf(-fabsf(z))); }

#define XB_TMO      128
#define XB_XCNT(j)  (256  + 64 * (j))
#define XB_XSUB(j)  (1280 + 64 * (j))
#define XB_XGEN(j)  (2304 + 64 * (j))
#define XB_TOP      3328
#define XB_TOPGEN   3392
#define XCD_BAR_WORDS 3456
#define XB_SPIN_CAP (1u << 18)
__device__ __forceinline__ unsigned xb_ld(unsigned* p)              { return __hip_atomic_load(p, __ATOMIC_RELAXED, __HIP_MEMORY_SCOPE_AGENT); }
__device__ __forceinline__ unsigned xb_add(unsigned* p, unsigned v) { return __hip_atomic_fetch_add(p, v, __ATOMIC_RELAXED, __HIP_MEMORY_SCOPE_AGENT); }
__device__ __forceinline__ unsigned xb_xcc_id() { return (unsigned)__builtin_amdgcn_s_getreg((3 << 11) | 20) & 0xFu; }
#define XB_SPIN(cond, bar) do { unsigned _sp = 0; while (cond) { __builtin_amdgcn_s_sleep(1); \
    if ((++_sp & 255u) == 0u) { if (xb_ld(&(bar)[XB_TMO])) break; if (_sp > XB_SPIN_CAP) { atomicAdd(&(bar)[XB_TMO], 1u); break; } } } } while (0)
struct XcdBarrier { unsigned* bar; unsigned x; volatile LAS unsigned* st; };
__device__ __forceinline__ XcdBarrier xcd_barrier_post(unsigned* bar, volatile LAS unsigned* st) {
    XcdBarrier b; b.bar = bar; b.x = xb_xcc_id(); b.st = st;
    if (threadIdx.x == 0) (void)xb_add(&bar[XB_XCNT(b.x)], 1u);
    return b;
}
__device__ __forceinline__ void xcd_barrier_complete(unsigned* bar, unsigned x, unsigned& nloc, unsigned& nx) {
    const unsigned G = gridDim.x * gridDim.y * gridDim.z;
    unsigned sum, cnt, mine, sp = 0u;
    for (;;) {
        sum = 0u; cnt = 0u; mine = 0u;
#pragma unroll
        for (unsigned j = 0; j < 16; ++j) { const unsigned c = xb_ld(&bar[XB_XCNT(j)]); sum += c; cnt += (c > 0u) ? 1u : 0u; mine = (j == x) ? c : mine; }
        if (sum == G) break;
        __builtin_amdgcn_s_sleep(1);
        if ((++sp & 255u) == 0u) { if (xb_ld(&bar[XB_TMO])) break; if (sp > XB_SPIN_CAP) { atomicAdd(&bar[XB_TMO], 1u); break; } }
    }
    nloc = mine > 0u ? mine : 1u; nx = cnt > 0u ? cnt : 1u;
}
__device__ __forceinline__ void xcd_barrier(const XcdBarrier& b) {
    asm volatile("s_waitcnt vmcnt(0)" ::: "memory");
    __syncthreads();
    if (threadIdx.x == 0) {
        unsigned* bar = b.bar;
        __builtin_amdgcn_s_waitcnt(0);
        unsigned nloc = b.st[0], nx = b.st[1];
        if (nloc == 0u) { xcd_barrier_complete(bar, b.x, nloc, nx); b.st[0] = nloc; b.st[1] = nx; }
        const unsigned old = xb_add(&bar[XB_XSUB(b.x)], 1u);
        const unsigned gen = old / nloc;
        if (old + 1u == (gen + 1u) * nloc) {
            __builtin_amdgcn_fence(__ATOMIC_RELEASE, "agent");
            asm volatile("s_waitcnt vmcnt(0)" ::: "memory");
            const unsigned og = xb_add(&bar[XB_TOP], 1u);
            const unsigned tg = og / nx;
            if (og + 1u == (tg + 1u) * nx) xb_add(&bar[XB_TOPGEN], 1u);
            else XB_SPIN(xb_ld(&bar[XB_TOPGEN]) == tg, bar);
            __builtin_amdgcn_fence(__ATOMIC_ACQUIRE, "agent");
            xb_add(&bar[XB_XGEN(b.x)], 1u);
            asm volatile("s_waitcnt vmcnt(0)" ::: "memory");
        } else {
            XB_SPIN(xb_ld(&bar[XB_XGEN(b.x)]) == gen, bar);
            __builtin_amdgcn_fence(__ATOMIC_ACQUIRE, "agent");
            asm volatile("s_waitcnt vmcnt(0)" ::: "memory");
        }
    }
    __syncthreads();
}

struct Args { const float* in[14]; float* out; unsigned char* ws; int ph_lo, ph_hi; };
typedef const __attribute__((address_space(4))) Args* KArgs;
struct Frame {
    LAS unsigned char* lds;
    int tid, lane, wave, vcu, G;
    KArgs ka; unsigned char* ws;
    __device__ __forceinline__ const float* in(int k) const { return ka->in[k]; }
};
#define F_x F.in(0)
#define F_c F.in(1)
#define F_norm_g F.in(2)
#define F_w_ada F.in(3)
#define F_b_ada F.in(4)
#define F_w_in F.in(5)
#define F_w_fmap F.in(6)
#define F_w_af F.in(7)
#define F_b_af F.in(8)
#define F_w_ab F.in(9)
#define F_b_ab F.in(10)
#define F_gla_g F.in(11)
#define F_w_out F.in(12)
#define F_final_g F.in(13)
__device__ __forceinline__ Frame make_frame(LAS unsigned char* lds) {
    Frame F; F.lds = lds;
    int t = threadIdx.x; asm volatile("" : "+v"(t));
    KArgs ka = (KArgs)__builtin_amdgcn_kernarg_segment_ptr(); asm volatile("" : "+s"(ka));
    F.ka = ka; F.ws = ka->ws;
    F.tid = t; F.lane = t & 63; F.wave = __builtin_amdgcn_readfirstlane(t >> 6);
    F.G = gridDim.x; { const int bx = blockIdx.x; F.vcu = (F.G % 8 == 0) ? (bx % 8) * (F.G / 8) + bx / 8 : bx; }
    return F;
}

struct EpiProj {
    static constexpr bool PERM = true, AFTER_DRAIN = false;
    const float* ssq; const float* sw;
    unsigned char* ws;
    __device__ __forceinline__ void operator()(const pg8::f32x4 (&acc)[2][2][4][2], const pg8::Unit& u, int wr, int wc, int fr, int fq) const {
        const int b = u.pm >> 3, pn = u.pn;
        bf16* dst; int ldc, dcol; int mode;
        if (pn < 4) { dst = (bf16*)(ws + WS_ZF); ldc = 1024; dcol = pn * 256; mode = 1; }
        else if (pn < 6) { dst = (bf16*)(ws + WS_Q); ldc = 512; dcol = (pn - 4) * 256; mode = 2; }
        else if (pn < 8) { dst = (bf16*)(ws + WS_K); ldc = 512; dcol = (pn - 6) * 256; mode = 0; }
        else if (pn < 12) { dst = (bf16*)(ws + WS_V); ldc = 1024; dcol = (pn - 8) * 256; mode = 0; }
        else { dst = (bf16*)(ws + WS_R); ldc = 1024; dcol = (pn - 12) * 256; mode = 1; }
        const int col0 = wc * 32 + 8 * fq;
        pg8::f32x4 bv[2][2];
#pragma unroll
        for (int bj = 0; bj < 2; ++bj)
#pragma unroll
            for (int n = 0; n < 2; ++n) bv[bj][n] = *(const pg8::f32x4*)(sw + (size_t)b * NSW + 2048 + pn * 256 + col0 + bj * 128 + 4 * n);
#pragma unroll
        for (int ai = 0; ai < 2; ++ai)
#pragma unroll
            for (int m = 0; m < 4; ++m) {
                const int row = u.pm * 256 + ai * 128 + wr * 64 + m * 16 + fr;
                const pg8::f32x4 p = *(const pg8::f32x4*)(ssq + (size_t)row * 4);
                const float rs = rsqrtf(((p[0] + p[1]) + (p[2] + p[3])) * (1.f / 1024.f) + EPS);
                bf16* rowp = dst + (size_t)row * ldc + dcol + col0;
#pragma unroll
                for (int bj = 0; bj < 2; ++bj) {
                    pg8::f32x4 v0 = acc[ai][bj][m][0] * rs + bv[bj][0], v1 = acc[ai][bj][m][1] * rs + bv[bj][1];
                    if (mode == 1) {
#pragma unroll
                        for (int j = 0; j < 4; ++j) { v0[j] = silu_f(v0[j]); v1[j] = silu_f(v1[j]); }
                    } else if (mode == 2) { v0 = v0 * 0.08838834764831845f; v1 = v1 * 0.08838834764831845f; }
                    pg8::u32x4 w; w.x = pg8::cvt_pk_bf16(v0[0], v0[1]); w.y = pg8::cvt_pk_bf16(v0[2], v0[3]); w.z = pg8::cvt_pk_bf16(v1[0], v1[1]); w.w = pg8::cvt_pk_bf16(v1[2], v1[3]);
                    *(pg8::u32x4*)(rowp + bj * 128) = w;
                }
            }
    }
};
struct EpiAB {
    static constexpr bool PERM = true, AFTER_DRAIN = false;
    const float* ssq; const float* sw; bf16* abT;
    __device__ __forceinline__ void operator()(const pg8::f32x4 (&acc)[2][2][4][2], const pg8::Unit& u, int wr, int wc, int fr, int fq) const {
        const int b = u.pn >> 3, pos0 = (u.pn & 7) * 256 + wc * 32 + 8 * fq, tok0 = u.pn * 256 + wc * 32 + 8 * fq;
        pg8::f32x4 rs[2][2];
#pragma unroll
        for (int bj = 0; bj < 2; ++bj)
#pragma unroll
            for (int n = 0; n < 2; ++n)
#pragma unroll
                for (int j = 0; j < 4; ++j) {
                    const pg8::f32x4 p = *(const pg8::f32x4*)(ssq + (size_t)(tok0 + bj * 128 + 4 * n + j) * 4);
                    rs[bj][n][j] = rsqrtf(((p[0] + p[1]) + (p[2] + p[3])) * (1.f / 1024.f) + EPS);
                }
#pragma unroll
        for (int ai = 0; ai < 2; ++ai)
#pragma unroll
            for (int m = 0; m < 4; ++m) {
                const int np = u.pm * 256 + ai * 128 + wr * 64 + m * 16 + fr;
                const float bias = sw[(size_t)b * NSW + np];
                bf16* rowp = abT + ((size_t)(b * 1024 + (np & 1023)) * 4096 + (size_t)(np >> 10) * 2048 + pos0);
#pragma unroll
                for (int bj = 0; bj < 2; ++bj) {
                    const pg8::f32x4 v0 = acc[ai][bj][m][0] * rs[bj][0] + bias, v1 = acc[ai][bj][m][1] * rs[bj][1] + bias;
                    pg8::u32x4 w; w.x = pg8::cvt_pk_bf16(v0[0], v0[1]); w.y = pg8::cvt_pk_bf16(v0[2], v0[3]); w.z = pg8::cvt_pk_bf16(v1[0], v1[1]); w.w = pg8::cvt_pk_bf16(v1[2], v1[3]);
                    *(pg8::u32x4*)(rowp + bj * 128) = w;
                }
            }
    }
};
struct EpiDft {
    static constexpr bool PERM = true, AFTER_DRAIN = false;
    bf16* zf;
    __device__ __forceinline__ void operator()(const pg8::f32x4 (&acc)[2][2][4][2], const pg8::Unit& u, int wr, int wc, int fr, int fq) const {
        const int col0 = u.pn * 256 + wc * 32 + 8 * fq;
#pragma unroll
        for (int ai = 0; ai < 2; ++ai)
#pragma unroll
            for (int m = 0; m < 4; ++m) {
                const int tok = u.bz * 2048 + u.pm * 256 + ai * 128 + wr * 64 + m * 16 + fr;
                bf16* rowp = zf + (size_t)tok * 1024 + col0;
#pragma unroll
                for (int bj = 0; bj < 2; ++bj) {
                    const pg8::u32x4 z = *(const pg8::u32x4*)(rowp + bj * 128);
                    const pg8::f32x4 a0 = acc[ai][bj][m][0], a1 = acc[ai][bj][m][1];
                    pg8::u32x4 w;
                    w.x = pg8::cvt_pk_bf16(a0[0] * bflo(z.x), a0[1] * bfhi(z.x)); w.y = pg8::cvt_pk_bf16(a0[2] * bflo(z.y), a0[3] * bfhi(z.y));
                    w.z = pg8::cvt_pk_bf16(a1[0] * bflo(z.z), a1[1] * bfhi(z.z)); w.w = pg8::cvt_pk_bf16(a1[2] * bflo(z.w), a1[3] * bfhi(z.w));
                    *(pg8::u32x4*)(rowp + bj * 128) = w;
                }
            }
    }
};
struct EpiOut {
    static constexpr bool PERM = false, AFTER_DRAIN = true;
    const float* xin; float* xout; bf16* xg; float* ssq; const float* gate; const float* gmodn;
    __device__ __forceinline__ void fused(pg8::f32x4 (&acc)[2][2][4][2], const pg8::Unit& u, int wr, int wc, int fr, int fq, PG8_LAS unsigned char* lds, int wid, int lane) const {
        const int b = u.pm >> 3, col0 = u.pn * 256 + wc * 32 + 4 * fq;
        PG8_LAS float* P = (PG8_LAS float*)lds;
        pg8::f32x4 gt[2][2], gm[2][2];
#pragma unroll
        for (int bj = 0; bj < 2; ++bj)
#pragma unroll
            for (int n = 0; n < 2; ++n) {
                gt[bj][n] = *(const pg8::f32x4*)(gate + (size_t)b * 3072 + col0 + bj * 128 + n * 16);
                gm[bj][n] = gmodn ? *(const pg8::f32x4*)(gmodn + (size_t)b * 1024 + col0 + bj * 128 + n * 16) : (pg8::f32x4){0.f, 0.f, 0.f, 0.f};
            }
#pragma unroll
        for (int ai = 0; ai < 2; ++ai)
#pragma unroll
            for (int m = 0; m < 4; ++m) {
                const int rl = ai * 128 + wr * 64 + m * 16 + fr; const size_t off = (size_t)(u.pm * 256 + rl) * 1024 + col0;
                float s = 0.f;
#pragma unroll
                for (int bj = 0; bj < 2; ++bj)
#pragma unroll
                    for (int n = 0; n < 2; ++n) {
                        const pg8::f32x4 xv = *(const pg8::f32x4*)(xin + off + bj * 128 + n * 16);
                        const pg8::f32x4 o = xv + gt[bj][n] * acc[ai][bj][m][n];
                        *(pg8::f32x4*)(xout + off + bj * 128 + n * 16) = o;
                        s += (o[0] * o[0] + o[1] * o[1]) + (o[2] * o[2] + o[3] * o[3]);
                        if (gmodn) { const pg8::f32x4 h = o * gm[bj][n]; pg8::u32x2 w; w.x = pg8::cvt_pk_bf16(h[0], h[1]); w.y = pg8::cvt_pk_bf16(h[2], h[3]); *(pg8::u32x2*)(xg + off + bj * 128 + n * 16) = w; }
                    }
                s += __shfl_xor(s, 16); s += __shfl_xor(s, 32);
                if (fq == 0) P[rl * 4 + wc] = s;
            }
        asm volatile("s_waitcnt lgkmcnt(0)" ::: "memory"); __builtin_amdgcn_s_barrier(); asm volatile("" ::: "memory");
        const int t = wid * 64 + lane;
        if (t < 256) { const float s = (P[t * 4 + 0] + P[t * 4 + 1]) + (P[t * 4 + 2] + P[t * 4 + 3]); ssq[(size_t)(u.pm * 256 + t) * 4 + u.pn] = s; }
    }
};

__device__ __forceinline__ void smallm_item(const Frame& F, const float* W, int ldw, int n0, int ncols, const float* bias, float* out, int ldo, LAS float* sv, LAS float* red) {
    const int cg = F.lane & 15, kq = F.lane >> 4, w = F.wave;
    float acc[8][4];
#pragma unroll
    for (int b = 0; b < 8; ++b)
#pragma unroll
        for (int j = 0; j < 4; ++j) acc[b][j] = 0.f;
    const bool ok = (n0 + 4 * cg) < ncols;
    const float* wp = W + (size_t)(128 * w + kq) * ldw + n0 + 4 * cg;
#pragma unroll 4
    for (int s = 0; s < 32; ++s) {
        const int k = 128 * w + 4 * s + kq;
        f32x4 wv = (f32x4){0.f, 0.f, 0.f, 0.f};
        if (ok) wv = *(const f32x4*)(wp + (size_t)(4 * s) * ldw);
        const f32x4 s0 = *(const LAS f32x4*)(sv + k * 8), s1 = *(const LAS f32x4*)(sv + k * 8 + 4);
#pragma unroll
        for (int j = 0; j < 4; ++j) {
            acc[0][j] += s0[0] * wv[j]; acc[1][j] += s0[1] * wv[j]; acc[2][j] += s0[2] * wv[j]; acc[3][j] += s0[3] * wv[j];
            acc[4][j] += s1[0] * wv[j]; acc[5][j] += s1[1] * wv[j]; acc[6][j] += s1[2] * wv[j]; acc[7][j] += s1[3] * wv[j];
        }
    }
#pragma unroll
    for (int b = 0; b < 8; ++b)
#pragma unroll
        for (int j = 0; j < 4; ++j) { float v = acc[b][j]; v += __shfl_xor(v, 16); v += __shfl_xor(v, 32); acc[b][j] = v; }
    if (kq == 0) {
#pragma unroll
        for (int b = 0; b < 8; ++b) *(LAS f32x4*)(red + (w * 8 + b) * 64 + 4 * cg) = (f32x4){acc[b][0], acc[b][1], acc[b][2], acc[b][3]};
    }
    __syncthreads();
    { const int b = F.tid >> 6, c = F.tid & 63; float s = 0.f;
#pragma unroll
      for (int ww = 0; ww < 8; ++ww) s += red[(ww * 8 + b) * 64 + c];
      if (n0 + c < ncols) out[(size_t)b * ldo + n0 + c] = s + (bias ? bias[n0 + c] : 0.f); }
    __syncthreads();
}
__device__ __forceinline__ void transpose_item(const float* W, int ldw, bf16* WT, int ldo, LAS float* scr, int lane) {
#pragma unroll 8
    for (int i = 0; i < 32; ++i) { const int kk = 2 * i + (lane >> 5); scr[kk * 33 + (lane & 31)] = W[(size_t)kk * ldw + (lane & 31)]; }
    LDS_WAIT(); asm volatile("" ::: "memory");
    const int c = lane & 7;
#pragma unroll
    for (int j = 0; j < 4; ++j) { const int n = (lane >> 3) + 8 * j; const LAS float* s = scr + (8 * c) * 33 + n;
        v4u o; o.x = pk2(s[0 * 33], s[1 * 33]); o.y = pk2(s[2 * 33], s[3 * 33]); o.z = pk2(s[4 * 33], s[5 * 33]); o.w = pk2(s[6 * 33], s[7 * 33]);
        *(GAS v4u*)(WT + (size_t)n * ldo + 8 * c) = o; }
    LDS_WAIT(); asm volatile("" ::: "memory");
}

__device__ __forceinline__ void phase_p0(const Frame& F) {
    LAS float* sv = (LAS float*)F.lds;
    LAS float* red = (LAS float*)(F.lds + 32768);
    for (int e = F.tid; e < 8192; e += NTHR) { const int k = e >> 3, b = e & 7; sv[e] = silu_f(F_c[b * 1024 + k]); }
    __syncthreads();
    float* mod = (float*)(F.ws + WS_MOD);
    for (int it = F.vcu; it < 4 * 48; it += F.G) { const int l = it / 48, ch = it % 48;
        smallm_item(F, F_w_ada + (size_t)l * 1024 * 3072, 3072, ch * 64, 3072, F_b_ada + l * 3072, mod + (size_t)l * 8 * 3072, 3072, sv, red); }
    __syncthreads();
    LAS float* scr = (LAS float*)(F.lds + F.wave * 16384);
    const int gw = F.vcu * NWAVES + F.wave, NGW = F.G * NWAVES;
    constexpr int I_IN = 16 * 129, I_OUT = 32 * 32, I_L = I_IN + I_OUT;
    bf16* wtin = (bf16*)(F.ws + WS_WTIN); bf16* wtg = (bf16*)(F.ws + WS_WTG); bf16* wtout = (bf16*)(F.ws + WS_WTOUT);
    for (int it = gw; it < 4 * I_L; it += NGW) {
        const int l = it / I_L; int r = it % I_L;
        if (r < I_IN) { const int kb = r / 129, nb = r % 129; const float* W = F_w_in + (size_t)l * 1024 * DIN + (size_t)(64 * kb) * DIN + 1024 + 32 * nb;
            bf16* WT = (nb < 128) ? wtin + ((size_t)l * NPJ + 2048 + 32 * nb) * 1024 + 64 * kb : wtg + ((size_t)l * 32) * 1024 + 64 * kb;
            transpose_item(W, DIN, WT, 1024, scr, F.lane); }
        else { r -= I_IN; const int kb = r / 32, nb = r % 32; const float* W = F_w_out + (size_t)l * 2048 * 1024 + (size_t)(64 * kb) * 1024 + 32 * nb;
            transpose_item(W, 1024, wtout + ((size_t)l * 1024 + 32 * nb) * 2048 + 64 * kb, 2048, scr, F.lane); }
    }
    unsigned* ft = (unsigned*)(F.ws + WS_FTAB);
    const int gt = F.vcu * NTHR + F.tid, NGT = F.G * NTHR;
    for (int e = gt; e < 2048 * 2048; e += NGT) { const int p = e >> 11, k2 = (e & 2047) * 2;
        float v[2];
#pragma unroll
        for (int j = 0; j < 2; ++j) { const int k = k2 + j; const int idx = (p * (k & 2047)) & 2047; float sn, cs; sincospif((float)idx * (1.f / 1024.f), &sn, &cs);
            v[j] = (k < 2048 ? cs : -sn) * 0.02209708691207961f; }
        ft[e] = pk2(v[0], v[1]); }
}

__device__ __forceinline__ void phase_p1(const Frame& F) {
    const float* mod = (const float*)(F.ws + WS_MOD);
    float* gmod = (float*)(F.ws + WS_GMOD);
    const int gt = F.vcu * NTHR + F.tid, NGT = F.G * NTHR;
    for (int e = gt; e < 4 * 8 * 1024; e += NGT) { const int l = e >> 13, b = (e >> 10) & 7, k = e & 1023; gmod[e] = F_norm_g[l * 1024 + k] * (1.f + mod[((size_t)l * 8 + b) * 3072 + 1024 + k]); }
    const int gw = F.vcu * NWAVES + F.wave, NGW = F.G * NWAVES;
    bf16* xg = (bf16*)(F.ws + WS_XG); float* ssq = (float*)(F.ws + WS_SSQ);
    for (int row = gw; row < MTOK; row += NGW) { const int b = row >> 11; float s = 0.f;
#pragma unroll
        for (int j = 0; j < 4; ++j) { const int k = 4 * F.lane + 256 * j; const f32x4 xv = *(const f32x4*)(F_x + (size_t)row * 1024 + k);
            const f32x4 ng = *(const f32x4*)(F_norm_g + k); const f32x4 sc = *(const f32x4*)(mod + (size_t)b * 3072 + 1024 + k);
            s += (xv[0] * xv[0] + xv[1] * xv[1]) + (xv[2] * xv[2] + xv[3] * xv[3]);
            const f32x4 h = xv * (ng * (sc + 1.f)); v2u w; w.x = pk2(h[0], h[1]); w.y = pk2(h[2], h[3]); *(v2u*)(xg + (size_t)row * 1024 + k) = w; }
#pragma unroll
        for (int o = 1; o < 64; o <<= 1) s += __shfl_xor(s, o);
        if (F.lane == 0) *(f32x4*)(ssq + (size_t)row * 4) = (f32x4){s, 0.f, 0.f, 0.f}; }
    LAS float* sv = (LAS float*)F.lds; LAS float* red = (LAS float*)(F.lds + 32768);
    float* swraw = (float*)(F.ws + WS_SWRAW);
    int curl = -1;
    for (int it = F.vcu; it < 4 * 81; it += F.G) { const int l = it / 81, ch = it % 81;
        if (l != curl) { __syncthreads(); for (int e = F.tid; e < 8192; e += NTHR) { const int k = e >> 3, b = e & 7; sv[e] = mod[((size_t)l * 8 + b) * 3072 + k]; } __syncthreads(); curl = l; }
        smallm_item(F, F_w_in + (size_t)l * 1024 * DIN, DIN, ch * 64, DIN, nullptr, swraw + (size_t)l * 8 * DIN, DIN, sv, red); }
    __syncthreads();
    LAS float* ct = (LAS float*)F.lds;
    if (F.tid < 256) { float sn, cs; sincospif((float)F.tid * (1.f / 128.f), &sn, &cs); ct[F.tid] = cs * 0.0625f; }
    __syncthreads();
    float* wc = (float*)(F.ws + WS_WC);
    for (int e = gt; e < 4 * 4 * 2 * 256 * 256; e += NGT) { const int d = e & 255, c = (e >> 8) & 255, part = (e >> 16) & 1, lg = e >> 17;
        const float* wf = F_w_fmap + (size_t)lg * 65536 + d; float s = 0.f;
        for (int cp = 0; cp < 256; ++cp) { const int idx = (c * cp - (part ? 64 : 0)) & 255; s += ct[idx] * wf[(size_t)cp * 256]; }
        wc[e] = s; }
    __syncthreads();
}

__device__ __forceinline__ void phase_p2(const Frame& F) {
    const float* wc = (const float*)(F.ws + WS_WC);
    bf16* wtin = (bf16*)(F.ws + WS_WTIN);
    LAS float* Ls = (LAS float*)F.lds;
    LAS float* Lw = (LAS float*)(F.lds + 4096);
    const int td = F.tid & 15, tk = F.tid >> 4;
    for (int it = F.vcu; it < 4 * 2 * 4 * 4 * 16; it += F.G) {
        const int kt = it & 15, dt = (it >> 4) & 3, g = (it >> 6) & 3, part = (it >> 8) & 1, l = it >> 9;
        const float* wcb = wc + ((size_t)((l * 4 + g) * 2 + part)) * 65536 + dt * 64;
        const float* wib = F_w_in + (size_t)l * 1024 * DIN + (size_t)(kt * 64) * DIN + g * 256;
        float acc[4][2];
#pragma unroll
        for (int i = 0; i < 4; ++i) { acc[i][0] = 0.f; acc[i][1] = 0.f; }
        for (int c0 = 0; c0 < 256; c0 += 16) {
            __syncthreads();
            for (int e = F.tid; e < 1024; e += NTHR) { const int cc = e >> 6, dd = e & 63; Ls[e] = wcb[(size_t)(c0 + cc) * 256 + dd]; }
            for (int e = F.tid; e < 1024; e += NTHR) { const int kk = e >> 4, cc = e & 15; Lw[kk * 17 + cc] = wib[(size_t)kk * DIN + c0 + cc]; }
            __syncthreads();
#pragma unroll
            for (int cc = 0; cc < 16; ++cc) { const f32x4 sv = *(const LAS f32x4*)(Ls + cc * 64 + 4 * td); const float w0 = Lw[(2 * tk) * 17 + cc], w1 = Lw[(2 * tk + 1) * 17 + cc];
#pragma unroll
                for (int i = 0; i < 4; ++i) { acc[i][0] += sv[i] * w0; acc[i][1] += sv[i] * w1; } }
        }
#pragma unroll
        for (int i = 0; i < 4; ++i) { const int np = part * 1024 + g * 256 + dt * 64 + 4 * td + i;
            *(unsigned*)(wtin + ((size_t)l * NPJ + np) * 1024 + kt * 64 + 2 * tk) = pk2(acc[i][0], acc[i][1]); }
    }
    __syncthreads();
    const float* swraw = (const float*)(F.ws + WS_SWRAW); float* sw = (float*)(F.ws + WS_SW);
    const int gt = F.vcu * NTHR + F.tid, NGT = F.G * NTHR;
    for (int e = gt; e < 4 * 8 * NSW; e += NGT) { const int np = e % NSW, lb = e / NSW, l = lb >> 3; float s;
        if (np < 2048) { const int part = np >> 10, g = (np >> 8) & 3, d = np & 255; const float* wcb = wc + ((size_t)((l * 4 + g) * 2 + part)) * 65536 + d; const float* su = swraw + (size_t)lb * DIN + g * 256;
            s = 0.f; for (int c = 0; c < 256; ++c) s += su[c] * wcb[(size_t)c * 256]; }
        else if (np < NPJ) s = swraw[(size_t)lb * DIN + np - 1024];
        else s = swraw[(size_t)lb * DIN + 5120 + (np - NPJ)];
        sw[e] = s; }
}

__device__ __forceinline__ void gate_rows(const Frame& F, int l) {
    const bf16* xg = (const bf16*)(F.ws + WS_XG); const bf16* wtg = (const bf16*)(F.ws + WS_WTG) + (size_t)l * 32 * 1024;
    const float* ssq = (const float*)(F.ws + WS_SSQ); const float* sw = (const float*)(F.ws + WS_SW) + (size_t)l * 8 * NSW; float* glow = (float*)(F.ws + WS_GLOW);
    const int gw = F.vcu * NWAVES + F.wave, NGW = F.G * NWAVES;
    for (int row = gw; row < MTOK; row += NGW) {
        float xv[16];
#pragma unroll
        for (int h = 0; h < 2; ++h) { const v4u u = *(const v4u*)(xg + (size_t)row * 1024 + 8 * F.lane + 512 * h);
            xv[8 * h + 0] = bflo(u.x); xv[8 * h + 1] = bfhi(u.x); xv[8 * h + 2] = bflo(u.y); xv[8 * h + 3] = bfhi(u.y); xv[8 * h + 4] = bflo(u.z); xv[8 * h + 5] = bfhi(u.z); xv[8 * h + 6] = bflo(u.w); xv[8 * h + 7] = bfhi(u.w); }
        float mine = 0.f;
#pragma unroll 4
        for (int j = 0; j < 32; ++j) { float s = 0.f;
#pragma unroll
            for (int h = 0; h < 2; ++h) { const v4u u = *(const v4u*)(wtg + (size_t)j * 1024 + 8 * F.lane + 512 * h);
                s += xv[8 * h + 0] * bflo(u.x) + xv[8 * h + 1] * bfhi(u.x) + xv[8 * h + 2] * bflo(u.y) + xv[8 * h + 3] * bfhi(u.y) + xv[8 * h + 4] * bflo(u.z) + xv[8 * h + 5] * bfhi(u.z) + xv[8 * h + 6] * bflo(u.w) + xv[8 * h + 7] * bfhi(u.w); }
#pragma unroll
            for (int o = 1; o < 64; o <<= 1) s += __shfl_xor(s, o);
            mine = (F.lane == j) ? s : mine; }
        if (F.lane < 32) { const f32x4 p = *(const f32x4*)(ssq + (size_t)row * 4); const float rs = rsqrtf(((p[0] + p[1]) + (p[2] + p[3])) * (1.f / 1024.f) + EPS);
            glow[(size_t)row * 32 + F.lane] = mine * rs + sw[(size_t)(row >> 11) * NSW + NPJ + F.lane]; }
    }
}

typedef float f32x16 __attribute__((ext_vector_type(16)));
typedef float f32x8 __attribute__((ext_vector_type(8)));
typedef short s16x8 __attribute__((ext_vector_type(8)));
typedef short s16x4 __attribute__((ext_vector_type(4)));
typedef __bf16 b16x8 __attribute__((ext_vector_type(8)));
__host__ __device__ __forceinline__ unsigned off_b(unsigned row, unsigned ch) { return 256u * row + 16u * (ch ^ (((row & 3) << 2) | ((row >> 2) & 3))); }
__host__ __device__ __forceinline__ unsigned off_v(unsigned row, unsigned ch) { return 1024u * (row >> 3) + 512u * (ch >> 2) + 64u * (row & 7) + 16u * ((ch & 3) ^ ((row >> 2) & 3)); }
__device__ __forceinline__ s16x4 tr_rd(LAS unsigned char* p) { return __builtin_amdgcn_ds_read_tr16_b64_v4i16((LAS s16x4*)p); }
__device__ __forceinline__ s16x8 cat8(s16x4 a, s16x4 b) { return __builtin_shufflevector(a, b, 0, 1, 2, 3, 4, 5, 6, 7); }
__device__ __forceinline__ s16x8 pack8(float a0, float a1, float a2, float a3, float a4, float a5, float a6, float a7) {
    const f32x8 v = {a0, a1, a2, a3, a4, a5, a6, a7}; return __builtin_bit_cast(s16x8, __builtin_convertvector(v, b16x8)); }
#define PACK_STEP(x, s) pack8(x[8 * (s)], x[8 * (s) + 1], x[8 * (s) + 2], x[8 * (s) + 3], x[8 * (s) + 4], x[8 * (s) + 5], x[8 * (s) + 6], x[8 * (s) + 7])
#define MFMA32(a, b, c) __builtin_amdgcn_mfma_f32_32x32x16_bf16((a), (b), (c), 0, 0, 0)

__device__ __forceinline__ void gla_prep(const Frame& F, int l) {
    bf16* Q = (bf16*)(F.ws + WS_Q); bf16* Kb = (bf16*)(F.ws + WS_K); bf16* QB = (bf16*)(F.ws + WS_QIB); bf16* KB2 = (bf16*)(F.ws + WS_KIB);
    const float* glow = (const float*)(F.ws + WS_GLOW); float* DEC = (float*)(F.ws + WS_DEC);
    LAS float* gl = (LAS float*)F.lds;
    LAS float* cumL = (LAS float*)(F.lds + 8192);
    for (int it = F.vcu; it < 8 * 4 * 32; it += F.G) {
        const int ch = it & 31, h = (it >> 5) & 3, b = it >> 7; const int tok0 = b * 2048 + ch * 64;
        __syncthreads();
        *(LAS f32x4*)(gl + F.tid * 4) = *(const f32x4*)(glow + (size_t)tok0 * 32 + F.tid * 4);
        __syncthreads();
        { const int d = F.tid & 127, half = (F.tid >> 7) & 1, dir = F.tid >> 8;
          const float* wa = (dir ? F_w_ab : F_w_af) + (size_t)l * 16 * 512 + h * 128 + d; const float bias = (dir ? F_b_ab : F_b_af)[l * 512 + h * 128 + d];
          float w[16];
#pragma unroll
          for (int r = 0; r < 16; ++r) w[r] = wa[r * 512];
          float run = 0.f;
          for (int ii = 0; ii < 32; ++ii) { const int i = half * 32 + ii, pos = dir ? 63 - i : i; float z = bias;
#pragma unroll
              for (int r4 = 0; r4 < 4; ++r4) { const f32x4 g = *(const LAS f32x4*)(gl + pos * 32 + dir * 16 + 4 * r4); z += g[0] * w[4 * r4] + g[1] * w[4 * r4 + 1] + g[2] * w[4 * r4 + 2] + g[3] * w[4 * r4 + 3]; }
              run += logsig_f(z) * 0.0625f; cumL[(dir * 64 + i) * 128 + d] = run; } }
        __syncthreads();
        if (F.tid < 256) { const int d = F.tid & 127, dir = F.tid >> 7; const float t0 = cumL[(dir * 64 + 31) * 128 + d]; const float ref = cumL[(dir * 64 + 32) * 128 + d] + t0, last = cumL[(dir * 64 + 63) * 128 + d] + t0;
            float* dp = DEC + ((size_t)(((b * 4 + h) * 2 + dir) * 32 + (dir ? 31 - ch : ch))) * 384 + d;
            dp[0] = __expf(ref); dp[128] = __expf(last); dp[256] = __expf(last - ref); }
#pragma unroll
        for (int k = 0; k < 2; ++k) { const int g = F.tid + 512 * k, pos = g >> 4, dg = g & 15; const size_t go = (size_t)(tok0 + pos) * 512 + h * 128 + 8 * dg;
            const v4u q8 = *(const v4u*)(Q + go), k8 = *(const v4u*)(Kb + go);
            float qf[8] = {bflo(q8.x), bfhi(q8.x), bflo(q8.y), bfhi(q8.y), bflo(q8.z), bfhi(q8.z), bflo(q8.w), bfhi(q8.w)};
            float kf[8] = {bflo(k8.x), bfhi(k8.x), bflo(k8.y), bfhi(k8.y), bflo(k8.z), bfhi(k8.z), bflo(k8.w), bfhi(k8.w)};
#pragma unroll
            for (int dir = 0; dir < 2; ++dir) { const int i = dir ? 63 - pos : pos; const LAS float* cb = cumL + dir * 64 * 128 + 8 * dg;
                float qo[8], ko[8];
#pragma unroll
                for (int j4 = 0; j4 < 2; ++j4) { const f32x4 ci = *(const LAS f32x4*)(cb + i * 128 + 4 * j4), c32 = *(const LAS f32x4*)(cb + 32 * 128 + 4 * j4), c31 = *(const LAS f32x4*)(cb + 31 * 128 + 4 * j4);
#pragma unroll
                    for (int j = 0; j < 4; ++j) { const float x = ci[j] - c32[j] - (i < 32 ? c31[j] : 0.f); qo[4 * j4 + j] = qf[4 * j4 + j] * __expf(x); ko[4 * j4 + j] = kf[4 * j4 + j] * __expf(-x); } }
                v4u wq, wk; wq.x = pk2(qo[0], qo[1]); wq.y = pk2(qo[2], qo[3]); wq.z = pk2(qo[4], qo[5]); wq.w = pk2(qo[6], qo[7]);
                wk.x = pk2(ko[0], ko[1]); wk.y = pk2(ko[2], ko[3]); wk.z = pk2(ko[4], ko[5]); wk.w = pk2(ko[6], ko[7]);
                *(v4u*)((dir ? QB : Q) + go) = wq; *(v4u*)((dir ? KB2 : Kb) + go) = wk; } }
    }
    __syncthreads();
}

__device__ __forceinline__ void gla_scan(const Frame& F) {
    const bf16* V = (const bf16*)(F.ws + WS_V); const float* DEC = (const float*)(F.ws + WS_DEC);
    LAS unsigned char* QI = F.lds; LAS unsigned char* KI = F.lds + 16384; LAS unsigned char* VV = F.lds + 32768; LAS float* DL = (LAS float*)(F.lds + 40960); LAS float* OP = (LAS float*)(F.lds + 49152);
    const int lane = F.lane, m = lane & 31, hh = lane >> 5, blk = (lane >> 4) & 1, q4 = (lane & 15) >> 2, p4 = lane & 3;
    const int t = F.wave >> 1, u = F.wave & 1;
    for (int it = F.vcu; it < 256; it += F.G) {
        const int dvs = it & 3, dir = (it >> 2) & 1, h = (it >> 3) & 3, b = it >> 5;
        const bf16* qiG = (const bf16*)(F.ws + (dir ? WS_QIB : WS_Q)); const bf16* kiG = (const bf16*)(F.ws + (dir ? WS_KIB : WS_K));
        bf16* O = (bf16*)(F.ws + (dir ? WS_OB : WS_OF));
        const float* decg = DEC + (size_t)(((b * 4 + h) * 2 + dir) * 32) * 384;
        f32x16 st;
#pragma unroll
        for (int r = 0; r < 16; ++r) st[r] = 0.f;
        v4u qreg[2], kreg[2], vreg; f32x4 dreg = {0.f, 0.f, 0.f, 0.f};
        const int qrow0 = F.tid >> 4, qch = F.tid & 15, vrow = F.tid >> 3, vch = F.tid & 7;
#define GLA_TOK(n, i) (b * 2048 + (dir ? 2047 - ((n) * 64 + (i)) : (n) * 64 + (i)))
#define GLA_LOAD(n) do { _Pragma("unroll") for (int k_ = 0; k_ < 2; ++k_) { const size_t go_ = (size_t)GLA_TOK(n, qrow0 + 32 * k_) * 512 + h * 128 + 8 * qch; qreg[k_] = *(const v4u*)(qiG + go_); kreg[k_] = *(const v4u*)(kiG + go_); } \
        vreg = *(const v4u*)(V + (size_t)GLA_TOK(n, vrow) * 1024 + h * 256 + dvs * 64 + 8 * vch); if (F.tid < 96) dreg = *(const f32x4*)(decg + (size_t)(n) * 384 + 4 * F.tid); } while (0)
        GLA_LOAD(0);
        for (int n = 0; n < 32; ++n) {
#pragma unroll
            for (int k = 0; k < 2; ++k) { *(LAS v4u*)(QI + off_b(qrow0 + 32 * k, qch)) = qreg[k]; *(LAS v4u*)(KI + off_b(qrow0 + 32 * k, qch)) = kreg[k]; }
            *(LAS v4u*)(VV + off_v(vrow, vch)) = vreg;
            if (F.tid < 96) *(LAS f32x4*)(DL + 4 * F.tid) = dreg;
            if (n + 1 < 32) GLA_LOAD(n + 1);
            __syncthreads();
            s16x8 kiA[2][2], qiB[2][2];
#pragma unroll
            for (int a = 0; a < 2; ++a)
#pragma unroll
                for (int s2 = 0; s2 < 2; ++s2) { kiA[a][s2] = *(const LAS s16x8*)(KI + off_b(32 * a + m, 4 * t + 2 * s2 + hh)); qiB[a][s2] = *(const LAS s16x8*)(QI + off_b(32 * a + m, 4 * t + 2 * s2 + hh)); }
            f32x16 P00, P01, P11;
#pragma unroll
            for (int r = 0; r < 16; ++r) { P00[r] = 0.f; P01[r] = 0.f; P11[r] = 0.f; }
#pragma unroll
            for (int s2 = 0; s2 < 2; ++s2) { P00 = MFMA32(kiA[0][s2], qiB[0][s2], P00); P01 = MFMA32(kiA[0][s2], qiB[1][s2], P01); P11 = MFMA32(kiA[1][s2], qiB[1][s2], P11); }
#pragma unroll
            for (int r = 0; r < 16; ++r) { const int jl = (r & 3) + 8 * (r >> 2) + 4 * hh; const bool keep = dir ? (jl < m) : (jl <= m); P00[r] = keep ? P00[r] : 0.f; P11[r] = keep ? P11[r] : 0.f; }
            f32x16 o0, o1;
#pragma unroll
            for (int r = 0; r < 16; ++r) { o0[r] = 0.f; o1[r] = 0.f; }
#pragma unroll
            for (int jt = 0; jt < 2; ++jt)
#pragma unroll
                for (int s2 = 0; s2 < 2; ++s2) {
                    const int rb = 32 * jt + 16 * s2 + 4 * hh + q4;
                    const s16x8 vb = cat8(tr_rd(VV + off_v(rb, 4 * u + 2 * blk + (p4 >> 1)) + 8 * (p4 & 1)), tr_rd(VV + off_v(rb + 8, 4 * u + 2 * blk + (p4 >> 1)) + 8 * (p4 & 1)));
                    if (jt == 0) { o0 = MFMA32(PACK_STEP(P00, s2), vb, o0); o1 = MFMA32(PACK_STEP(P01, s2), vb, o1); }
                    else o1 = MFMA32(PACK_STEP(P11, s2), vb, o1);
                }
            f32x16 ss;
#pragma unroll
            for (int g = 0; g < 4; ++g) { const f32x4 e = *(const LAS f32x4*)(DL + 32 * t + 8 * g + 4 * hh);
#pragma unroll
                for (int j = 0; j < 4; ++j) ss[4 * g + j] = st[4 * g + j] * e[j]; }
#pragma unroll
            for (int s2 = 0; s2 < 2; ++s2) {
                const s16x8 sb = PACK_STEP(ss, s2);
#pragma unroll
                for (int a = 0; a < 2; ++a) {
                    const s16x4 lo = *(const LAS s16x4*)(QI + off_b(32 * a + m, 4 * t + 2 * s2) + 8 * hh), hi = *(const LAS s16x4*)(QI + off_b(32 * a + m, 4 * t + 2 * s2 + 1) + 8 * hh);
                    if (a == 0) o0 = MFMA32(cat8(lo, hi), sb, o0); else o1 = MFMA32(cat8(lo, hi), sb, o1);
                }
            }
            f32x16 kv;
#pragma unroll
            for (int r = 0; r < 16; ++r) kv[r] = 0.f;
#pragma unroll
            for (int s4 = 0; s4 < 4; ++s4) {
                const int rb = 16 * s4 + 8 * hh + q4;
                const s16x8 ka = cat8(tr_rd(KI + off_b(rb, 4 * t + 2 * blk + (p4 >> 1)) + 8 * (p4 & 1)), tr_rd(KI + off_b(rb + 4, 4 * t + 2 * blk + (p4 >> 1)) + 8 * (p4 & 1)));
                const s16x8 vb = cat8(tr_rd(VV + off_v(rb, 4 * u + 2 * blk + (p4 >> 1)) + 8 * (p4 & 1)), tr_rd(VV + off_v(rb + 4, 4 * u + 2 * blk + (p4 >> 1)) + 8 * (p4 & 1)));
                kv = MFMA32(ka, vb, kv);
            }
#pragma unroll
            for (int g = 0; g < 4; ++g) { const f32x4 el = *(const LAS f32x4*)(DL + 128 + 32 * t + 8 * g + 4 * hh), er = *(const LAS f32x4*)(DL + 256 + 32 * t + 8 * g + 4 * hh);
#pragma unroll
                for (int j = 0; j < 4; ++j) st[4 * g + j] = st[4 * g + j] * el[j] + kv[4 * g + j] * er[j]; }
            { LAS float* op = OP + F.wave * 2048;
#pragma unroll
              for (int r = 0; r < 16; ++r) { const int il = (r & 3) + 8 * (r >> 2) + 4 * hh; op[il * 32 + m] = o0[r]; op[1024 + il * 32 + m] = o1[r]; } }
            __syncthreads();
            { const int i = F.tid >> 3, c8 = F.tid & 7, uu = c8 >> 2; f32x4 a0 = {0.f, 0.f, 0.f, 0.f}, a1 = {0.f, 0.f, 0.f, 0.f};
#pragma unroll
              for (int tt = 0; tt < 4; ++tt) { const LAS float* op = OP + (2 * tt + uu) * 2048 + (i >> 5) * 1024 + (i & 31) * 32 + 8 * (c8 & 3); a0 += *(const LAS f32x4*)op; a1 += *(const LAS f32x4*)(op + 4); }
              v4u w; w.x = pk2(a0[0], a0[1]); w.y = pk2(a0[2], a0[3]); w.z = pk2(a1[0], a1[1]); w.w = pk2(a1[2], a1[3]);
              *(v4u*)(O + (size_t)GLA_TOK(n, i) * 1024 + h * 256 + dvs * 64 + 8 * c8) = w; }
        }
#undef GLA_TOK
#undef GLA_LOAD
        __syncthreads();
    }
}

__device__ __forceinline__ void gla_finalize(const Frame& F, int l) {
    const bf16* Of = (const bf16*)(F.ws + WS_OF); const bf16* Ob = (const bf16*)(F.ws + WS_OB); bf16* R = (bf16*)(F.ws + WS_R);
    const float* gg = F_gla_g + l * 1024;
    const int gw = F.vcu * NWAVES + F.wave, NGW = F.G * NWAVES;
    for (int tok = gw; tok < MTOK; tok += NGW) {
        const size_t off = (size_t)tok * 1024 + 16 * F.lane;
        float o[16]; float ss = 0.f;
#pragma unroll
        for (int h = 0; h < 2; ++h) { const v4u a = *(const v4u*)(Of + off + 8 * h), c = *(const v4u*)(Ob + off + 8 * h);
            o[8 * h + 0] = bflo(a.x) + bflo(c.x); o[8 * h + 1] = bfhi(a.x) + bfhi(c.x); o[8 * h + 2] = bflo(a.y) + bflo(c.y); o[8 * h + 3] = bfhi(a.y) + bfhi(c.y);
            o[8 * h + 4] = bflo(a.z) + bflo(c.z); o[8 * h + 5] = bfhi(a.z) + bfhi(c.z); o[8 * h + 6] = bflo(a.w) + bflo(c.w); o[8 * h + 7] = bfhi(a.w) + bfhi(c.w); }
#pragma unroll
        for (int j = 0; j < 16; ++j) ss += o[j] * o[j];
        ss += __shfl_xor(ss, 1); ss += __shfl_xor(ss, 2); ss += __shfl_xor(ss, 4); ss += __shfl_xor(ss, 8);
        const float rs = rsqrtf(ss * (1.f / 256.f) + EPS);
#pragma unroll
        for (int h = 0; h < 2; ++h) { const v4u rr = *(const v4u*)(R + off + 8 * h); const f32x4 g0 = *(const f32x4*)(gg + 16 * F.lane + 8 * h), g1 = *(const f32x4*)(gg + 16 * F.lane + 8 * h + 4);
            v4u w;
            w.x = pk2(o[8 * h + 0] * rs * g0[0] * bflo(rr.x), o[8 * h + 1] * rs * g0[1] * bfhi(rr.x)); w.y = pk2(o[8 * h + 2] * rs * g0[2] * bflo(rr.y), o[8 * h + 3] * rs * g0[3] * bfhi(rr.y));
            w.z = pk2(o[8 * h + 4] * rs * g1[0] * bflo(rr.z), o[8 * h + 5] * rs * g1[1] * bfhi(rr.z)); w.w = pk2(o[8 * h + 6] * rs * g1[2] * bflo(rr.w), o[8 * h + 7] * rs * g1[3] * bfhi(rr.w));
            *(v4u*)(R + off + 8 * h) = w; }
    }
}

__device__ __forceinline__ void final_norm(const Frame& F) {
    const float* ssq = (const float*)(F.ws + WS_SSQ);
    const int gw = F.vcu * NWAVES + F.wave, NGW = F.G * NWAVES;
    for (int row = gw; row < MTOK; row += NGW) { const f32x4 p = *(const f32x4*)(ssq + (size_t)row * 4); const float rs = rsqrtf(((p[0] + p[1]) + (p[2] + p[3])) * (1.f / 1024.f) + EPS);
#pragma unroll
        for (int j = 0; j < 4; ++j) { const int k = 4 * F.lane + 256 * j; float* p4 = F.ka->out + (size_t)row * 1024 + k; const f32x4 xv = *(const f32x4*)p4; const f32x4 g = *(const f32x4*)(F_final_g + k);
            *(f32x4*)p4 = xv * rs * g; } }
}

constexpr int N_PRO = 3, PH_PER_LAYER = 5, N_PHASES = N_PRO + DEPTH * PH_PER_LAYER + 1;

__global__ void __launch_bounds__(NTHR, 2) mk_fwd(Args args) {
    extern __shared__ __attribute__((aligned(16))) unsigned char lds[];
    LAS unsigned char* const L = (LAS unsigned char*)lds;
    volatile LAS unsigned* MISC = (volatile LAS unsigned*)(L + MISC_OFF);
    if (threadIdx.x < 32) MISC[threadIdx.x] = 0u;
    __syncthreads();
    const int lo = args.ph_lo, hi = args.ph_hi;
    XcdBarrier bar; bar.bar = (unsigned*)(args.ws + WS_CTL) + CW_BAR; bar.x = 0; bar.st = nullptr;
    if (hi - lo > 1) bar = xcd_barrier_post((unsigned*)(args.ws + WS_CTL) + CW_BAR, MISC + 8);
#define IN(k) (lo <= (k) && (k) < hi)
#define SEAM(k) do { if (IN(k) && IN((k) + 1)) xcd_barrier(bar); } while (0)

    if (IN(0)) { const Frame F = make_frame(L); phase_p0(F); } SEAM(0);
    if (IN(1)) { const Frame F = make_frame(L); phase_p1(F); } SEAM(1);
    if (IN(2)) { const Frame F = make_frame(L); phase_p2(F); } SEAM(2);

    for (int l = 0; l < DEPTH; ++l) {
        const int pb = N_PRO + l * PH_PER_LAYER;
        if (IN(pb + 0)) {
            { const Frame F = make_frame(L);
              const bf16* wtin = (const bf16*)(F.ws + WS_WTIN) + (size_t)l * NPJ * 1024; const float* sw = (const float*)(F.ws + WS_SW) + (size_t)l * 8 * NSW;
              pg8::Gemm g{wtin, nullptr, (const bf16*)(F.ws + WS_XG), 1024, 1024, 1024, 16, 0, 0};
              pg8::StaticOrder S; S.init(2048, MTOK, F.G, (int)blockIdx.x);
              EpiAB E{(const float*)(F.ws + WS_SSQ), sw, (bf16*)(F.ws + WS_AB)};
              pg8::gemm_phase<EpiAB, pg8::StaticOrder, true>(F.lds, F.tid, g, S, E); }
            { const Frame F = make_frame(L);
              const bf16* wtin = (const bf16*)(F.ws + WS_WTIN) + (size_t)l * NPJ * 1024; const float* sw = (const float*)(F.ws + WS_SW) + (size_t)l * 8 * NSW;
              pg8::Gemm g{(const bf16*)(F.ws + WS_XG), nullptr, wtin + (size_t)2048 * 1024, 1024, 1024, 1024, 16, 0, 0};
              pg8::StaticOrder S; S.init(MTOK, 4096, F.G, (int)blockIdx.x);
              EpiProj E{(const float*)(F.ws + WS_SSQ), sw, F.ws};
              pg8::gemm_phase<EpiProj, pg8::StaticOrder, true>(F.lds, F.tid, g, S, E); }
            { const Frame F = make_frame(L); gate_rows(F, l); }
        }
        SEAM(pb + 0);
        if (IN(pb + 1)) {
            const Frame F = make_frame(L);
            pg8::Gemm g{(const bf16*)(F.ws + WS_FTAB), nullptr, (const bf16*)(F.ws + WS_AB), 4096, 4096, 4096, 64, 0, (size_t)1024 * 4096 * 2};
            pg8::BatchOrder S; S.init(2048, 1024, F.G, (int)blockIdx.x);
            EpiDft E{(bf16*)(F.ws + WS_ZF)};
            pg8::gemm_phase<EpiDft, pg8::BatchOrder, true>(F.lds, F.tid, g, S, E);
            { const Frame F2 = make_frame(L); gla_prep(F2, l); }
        }
        SEAM(pb + 1);
        if (IN(pb + 2)) { const Frame F = make_frame(L); gla_scan(F); }
        SEAM(pb + 2);
        if (IN(pb + 3)) { const Frame F = make_frame(L); gla_finalize(F, l); }
        SEAM(pb + 3);
        if (IN(pb + 4)) {
            const Frame F = make_frame(L);
            const float* mod = (const float*)(F.ws + WS_MOD);
            pg8::Gemm g{(const bf16*)(F.ws + WS_ZF), (const bf16*)(F.ws + WS_R), (const bf16*)(F.ws + WS_WTOUT) + (size_t)l * 1024 * 2048, 2048, 1024, 2048, 16, 0, 0};
            pg8::StaticOrder S; S.init(MTOK, 1024, F.G, (int)blockIdx.x);
            EpiOut E{l == 0 ? F_x : (const float*)F.ka->out, F.ka->out, (bf16*)(F.ws + WS_XG), (float*)(F.ws + WS_SSQ), mod + (size_t)l * 8 * 3072 + 2048,
                     l + 1 < DEPTH ? (const float*)(F.ws + WS_GMOD) + (size_t)(l + 1) * 8 * 1024 : nullptr};
            if (F.G == 256) pg8::gemm_phase<EpiOut, pg8::StaticOrder, false>(F.lds, F.tid, g, S, E);
        }
        SEAM(pb + 4);
    }
    if (IN(N_PHASES - 1)) { const Frame F = make_frame(L); final_norm(F); }
#undef IN
#undef SEAM
}

extern "C" void kernel_launch(void* const* d_in, const int* in_sizes, int n_in, void* d_out, int out_size, void* d_ws, size_t ws_size, hipStream_t stream) {
    static int grid = 0;
    if (grid == 0) {
        if (n_in != 14 || out_size != MTOK * D || ws_size < WS_END) { fprintf(stderr, "kernel_launch: unexpected problem (n_in %d, out %d, ws %zu < %zu)\n", n_in, out_size, ws_size, (size_t)WS_END); grid = -1; return; }
        int dev = 0, cus = 0;
        if (hipGetDevice(&dev) != hipSuccess || hipDeviceGetAttribute(&cus, hipDeviceAttributeMultiprocessorCount, dev) != hipSuccess) { grid = -1; return; }
        if (hipFuncSetAttribute((const void*)mk_fwd, hipFuncAttributeMaxDynamicSharedMemorySize, LDS_BYTES) != hipSuccess) { fprintf(stderr, "kernel_launch: hipFuncSetAttribute failed\n"); grid = -1; return; }
        (void)hipGetLastError();
        grid = cus;
        if (grid != 256) fprintf(stderr, "kernel_launch: %d CUs; built for 256\n", grid);
    }
    if (grid < 0) return;
    (void)hipMemsetAsync((char*)d_ws + WS_CTL, 0, CTL_ZERO_BYTES, stream);
    Args a{};
    for (int i = 0; i < 14; ++i) a.in[i] = (const float*)d_in[i];
    a.out = (float*)d_out; a.ws = (unsigned char*)d_ws;
#if MK_PER_PHASE
    for (int p = 0; p < N_PHASES; ++p) { a.ph_lo = p; a.ph_hi = p + 1; hipLaunchKernelGGL(mk_fwd, dim3(grid), dim3(NTHR), LDS_BYTES, stream, a); }
#else
    a.ph_lo = 0; a.ph_hi = N_PHASES; hipLaunchKernelGGL(mk_fwd, dim3(grid), dim3(NTHR), LDS_BYTES, stream, a);
#endif
}
```

```cpp
#include <hip/hip_runtime.h>
#include <cstdio>
#include <cstdint>

#ifndef MK_PER_PHASE
#define MK_PER_PHASE 0
#endif

namespace pg8 {
#define PG8_LAS __attribute__((address_space(3)))
typedef unsigned short bf16_t;
typedef short bf16x8 __attribute__((ext_vector_type(8)));
typedef float f32x4 __attribute__((ext_vector_type(4)));
typedef unsigned u32x4 __attribute__((ext_vector_type(4)));
typedef unsigned u32x2 __attribute__((ext_vector_type(2)));
constexpr int BM = 256, BK = 64, HALF = 128, HTB = HALF * BK * 2  , STAGE_BYTES = 8 * HTB, NXCD = 8, WGM = 8;

__host__ __device__ __forceinline__ int lds_byte(int r, int c) { const int st = (r >> 4) * 2 + (c >> 5), rr = r & 15, cc = c & 31, ob = rr * 64 + cc * 2; return st * 1024 + (ob ^ (((ob >> 9) & 1) << 5)); }
__host__ __device__ __forceinline__ void stage_rc(int b, int& R, int& C) { const int st = b / 1024, sb = b % 1024, swz = sb ^ (((sb >> 9) & 1) << 5); R = (st >> 1) * 16 + swz / 64; C = (st & 1) * 32 + (swz % 64) / 2; }
__host__ __device__ __forceinline__ int perm32(int rho) { const int n = rho >> 4, i = rho & 15; return 8 * (i >> 2) + 4 * n + (i & 3); }

struct Unit { int pm, pn, bz; unsigned aoff, boff, coff; };
struct Gemm { const bf16_t* A; const bf16_t* A2; const bf16_t* Bt; int K, lda, ldb, ksplit; };

struct StaticOrder {
    int nM, nN, nwg, G, c;
    __host__ __device__ void init(int M, int N, int G_, int c_) { nM = M / BM; nN = N / BM; nwg = nM * nN; G = G_; c = c_; }
    __host__ __device__ bool next(int i, Unit& u) const {
        const long L = (long)i * G + c; if (L >= nwg) return false;
        int wgid = (int)L; { const int q = nwg / NXCD, r = nwg % NXCD, xcd = wgid % NXCD, off = wgid / NXCD; wgid = (xcd < r ? xcd * (q + 1) : r * (q + 1) + (xcd - r) * q) + off; }
        const int nig = WGM * nN, gid = wgid / nig, fm = gid * WGM, gsz = (nM - fm) < WGM ? (nM - fm) : WGM;
        u.pm = fm + ((wgid % nig) % gsz); u.pn = (wgid % nig) / gsz; u.bz = 0; u.aoff = 0u; u.boff = 0u; u.coff = 0u; return true;
    }
};
struct BatchOrder {
    int nM, nN, G, c;
    __host__ __device__ void init(int M, int N, int G_, int c_) { nM = M / BM; nN = N / BM; G = G_; c = c_; }
    __host__ __device__ bool next(int i, Unit& u) const {
        const int per = nM * nN; const long L = (long)i * G + c; if (L >= 8L * per) return false;
        const int bz = (int)(L % 8), t = (int)(L / 8); u.bz = bz; u.pm = t / nN; u.pn = t % nN; u.aoff = 0u; u.boff = (unsigned)bz * (1024u * 4096u * 2u); u.coff = 0u; return true;
    }
};

struct WcOrder {
    int G, c;
    __host__ __device__ bool next(int i, Unit& u) const { const int L = i * G + c; if (L >= 32) return false;
        u.pm = 0; u.pn = 0; u.bz = L; u.aoff = (unsigned)(L >> 1) * 131072u; u.boff = (unsigned)(L & 1) * 131072u; u.coff = (unsigned)L * 65536u; return true; }
};
struct FoldOrder {
    int G, c;
    __host__ __device__ bool next(int i, Unit& u) const { const int L = i * G + c; if (L >= 128) return false;
        const int z = L >> 2, part = z & 1, g = (z >> 1) & 3, l = z >> 3;
        u.pm = 0; u.pn = L & 3; u.bz = z; u.aoff = (unsigned)z * 131072u; u.boff = (unsigned)(l * 1048576 + g * 256) * 2u; u.coff = (unsigned)((l * 6144 + part * 1024 + g * 256) * 1024); return true; }
};

typedef float f32x2_t __attribute__((ext_vector_type(2)));
typedef __bf16 b16x2_t __attribute__((ext_vector_type(2)));
__device__ __forceinline__ unsigned cvt_pk_bf16(float lo, float hi) { const f32x2_t v = {lo, hi}; return __builtin_bit_cast(unsigned, __builtin_convertvector(v, b16x2_t)); }

template <class Epi, class Sched, bool ALIGN_EPI>
__device__ __forceinline__ void gemm_phase(PG8_LAS unsigned char* lds, const int tid, const Gemm g, const Sched& S, const Epi& E) {
    const int wid = __builtin_amdgcn_readfirstlane(tid >> 6), lane = tid & 63, wr = wid >> 2, wc = wid & 3, fr = lane & 15, fq = lane >> 4;
    const int K = g.K, nt = K / BK, ks = g.ksplit;
    unsigned voffA[2], voffB[2];
#pragma unroll
    for (int i = 0; i < 2; ++i) { int R, C; stage_rc(tid * 16 + i * 8192, R, C); const int Rb = Epi::PERM ? ((R & ~31) + perm32(R & 31)) : R;
        voffA[i] = (unsigned)(R * g.lda + C) * 2u; voffB[i] = (unsigned)(Rb * g.ldb + C) * 2u; }
    const size_t kstep = (size_t)(BK * 2);
    const size_t hstepA = (size_t)HALF * g.lda * 2, tstepA = 2 * hstepA, hstepB = (size_t)HALF * g.ldb * 2, tstepB = 2 * hstepB;
    const unsigned ldsw = (unsigned)wid * 1024u;
    const int aoff = lds_byte(wr * 64 + fr, fq * 8), boff = lds_byte(wc * 32 + fr, fq * 8);
#define PG8_SA(b, h) (((b) * 2 + (h)) * HTB)
#define PG8_SB(b, h) ((4 + (b) * 2 + (h)) * HTB)
#define PG8_STAGE(bufoff, gbase, voff) do { _Pragma("unroll") for (int _i = 0; _i < 2; ++_i) \
        __builtin_amdgcn_global_load_lds((const unsigned*)((const char*)(gbase) + (voff)[_i]), (PG8_LAS unsigned*)(lds + (bufoff) + ldsw + _i * 8192), 16, 0, 0); } while (0)
#define PG8_LDA(dst, b, h) do { _Pragma("unroll") for (int m = 0; m < 4; ++m) _Pragma("unroll") for (int k = 0; k < 2; ++k) dst[m][k] = *(const PG8_LAS bf16x8*)(lds + PG8_SA(b, h) + aoff + m * 2048 + k * 1024); } while (0)
#define PG8_LDB(dst, b, h) do { _Pragma("unroll") for (int n = 0; n < 2; ++n) _Pragma("unroll") for (int k = 0; k < 2; ++k) dst[n][k] = *(const PG8_LAS bf16x8*)(lds + PG8_SB(b, h) + boff + n * 2048 + k * 1024); } while (0)
#define PG8_MMA(ai, bj, At, Bt) do { __builtin_amdgcn_s_setprio(1); _Pragma("unroll") for (int m = 0; m < 4; ++m) _Pragma("unroll") for (int n = 0; n < 2; ++n) _Pragma("unroll") for (int k = 0; k < 2; ++k) \
        acc[ai][bj][m][n] = __builtin_amdgcn_mfma_f32_16x16x32_bf16(Bt[n][k], At[m][k], acc[ai][bj][m][n], 0, 0, 0); __builtin_amdgcn_s_setprio(0); } while (0)
#define PG8_WAIT_V(n) asm volatile("s_waitcnt vmcnt(" #n ")" ::: "memory")
#define PG8_WAIT_L(n) asm volatile("s_waitcnt lgkmcnt(" #n ")" ::: "memory")
#define PG8_BAR __builtin_amdgcn_s_barrier()
#define PG8_SCHED __builtin_amdgcn_sched_barrier(0)
#define PG8_APT(b1, t) ((b1) + (long long)(t) * (long long)kstep + ((t) >= ks ? d2 : 0ll))
    Unit cur, nxt; int ui = 0;
    if (!S.next(0, cur)) return;
    f32x4 acc[2][2][4][2];
#pragma unroll
    for (int a = 0; a < 2; ++a)
#pragma unroll
        for (int b = 0; b < 2; ++b)
#pragma unroll
            for (int m = 0; m < 4; ++m)
#pragma unroll
                for (int n = 0; n < 2; ++n) acc[a][b][m][n] = (f32x4){0.f, 0.f, 0.f, 0.f};
    bf16x8 At[4][2], B0[2][2], B1[2][2];
    const char* cA = (const char*)g.A + (size_t)cur.aoff + (size_t)cur.pm * tstepA;
    const long long d2 = g.A2 ? ((const char*)g.A2 - (const char*)g.A) - (long long)ks * (long long)kstep : 0ll;
    const char* cB = (const char*)g.Bt + (size_t)cur.boff + (size_t)cur.pn * tstepB;
    PG8_STAGE(PG8_SB(0, 0), cB, voffB); PG8_STAGE(PG8_SB(0, 1), cB + hstepB, voffB); PG8_STAGE(PG8_SA(0, 0), cA, voffA); PG8_STAGE(PG8_SA(0, 1), cA + hstepA, voffA);
    if (wr == 1) PG8_BAR;
    PG8_WAIT_V(2); PG8_BAR;
    PG8_STAGE(PG8_SB(1, 0), cB + kstep, voffB); PG8_STAGE(PG8_SA(1, 0), cA + kstep, voffA); PG8_STAGE(PG8_SB(1, 1), cB + hstepB + kstep, voffB);
    PG8_WAIT_V(6); PG8_BAR;
    for (;;) {
        const bool has_next = S.next(ui + 1, nxt);
        const char* nA = has_next ? (const char*)g.A + (size_t)nxt.aoff + (size_t)nxt.pm * tstepA : cA;
        const char* nB = has_next ? (const char*)g.Bt + (size_t)nxt.boff + (size_t)nxt.pn * tstepB : cB;
#pragma nounroll
        for (int t = 0; t < nt; t += 2) {
            const bool last = (t == nt - 2);
            const char* a1 = PG8_APT(cA, t + 1);
            const char* a2 = last ? nA : PG8_APT(cA, t + 2); const char* b2 = last ? nB : cB + (size_t)(t + 2) * kstep;
            const char* a3 = last ? nA + kstep : PG8_APT(cA, t + 3); const char* b3 = b2 + kstep;
            PG8_LDB(B0, 0, 0); PG8_LDB(B1, 0, 1); PG8_SCHED; PG8_LDA(At, 0, 0); PG8_STAGE(PG8_SA(1, 1), a1 + hstepA, voffA);
            PG8_WAIT_V(8); PG8_WAIT_L(0); PG8_BAR; PG8_MMA(0, 0, At, B0); PG8_MMA(0, 1, At, B1); PG8_BAR; PG8_SCHED;
            PG8_LDA(At, 0, 1); PG8_STAGE(PG8_SB(0, 0), b2, voffB); PG8_STAGE(PG8_SB(0, 1), b2 + hstepB, voffB); PG8_STAGE(PG8_SA(0, 0), a2, voffA);
            PG8_WAIT_V(8); PG8_WAIT_L(0); PG8_BAR; PG8_MMA(1, 0, At, B0); PG8_MMA(1, 1, At, B1); PG8_BAR; PG8_SCHED;
            PG8_LDB(B0, 1, 0); PG8_LDB(B1, 1, 1); PG8_SCHED; PG8_LDA(At, 1, 0); PG8_STAGE(PG8_SA(0, 1), a2 + hstepA, voffA);
            PG8_WAIT_V(8); PG8_WAIT_L(0); PG8_BAR; PG8_MMA(0, 0, At, B0); PG8_MMA(0, 1, At, B1); PG8_BAR; PG8_SCHED;
            PG8_LDA(At, 1, 1); PG8_STAGE(PG8_SB(1, 0), b3, voffB); PG8_STAGE(PG8_SB(1, 1), b3 + hstepB, voffB); PG8_STAGE(PG8_SA(1, 0), a3, voffA);
            PG8_WAIT_V(8); PG8_WAIT_L(0); PG8_BAR; PG8_MMA(1, 0, At, B0); PG8_MMA(1, 1, At, B1); PG8_BAR; PG8_SCHED;
        }
        if constexpr (ALIGN_EPI) { if (wr == 0) PG8_BAR; }
        if constexpr (!Epi::AFTER_DRAIN) { E(acc, cur, wr, wc, fr, fq); }
        if (!has_next) break;
#pragma unroll
        for (int a = 0; a < 2; ++a)
#pragma unroll
            for (int b = 0; b < 2; ++b)
#pragma unroll
                for (int m = 0; m < 4; ++m)
#pragma unroll
                    for (int n = 0; n < 2; ++n) acc[a][b][m][n] = (f32x4){0.f, 0.f, 0.f, 0.f};
        cur = nxt; cA = nA; cB = nB; ++ui;
        if constexpr (ALIGN_EPI) { if (wr == 1) PG8_BAR; }
    }
    PG8_WAIT_V(0);
    if constexpr (!ALIGN_EPI) { if (wr == 0) PG8_BAR; }
    PG8_BAR;
    if constexpr (Epi::AFTER_DRAIN) { E.fused(acc, cur, wr, wc, fr, fq, lds, wid, lane); }
#undef PG8_SA
#undef PG8_SB
#undef PG8_STAGE
#undef PG8_LDA
#undef PG8_LDB
#undef PG8_MMA
#undef PG8_WAIT_V
#undef PG8_WAIT_L
#undef PG8_BAR
#undef PG8_SCHED
#undef PG8_APT
}
}

constexpr int NWAVES = 8, NTHR = NWAVES * 64;
constexpr int D = 1024, BATCH = 8, SEQ = 2048, DEPTH = 4, MTOK = BATCH * SEQ;
constexpr int DIN = 5152;
constexpr int NPJ = 6144;
constexpr int NSW = 6176;
constexpr float EPS = 1e-6f;

constexpr size_t MiB = 1u << 20;
constexpr size_t WS_CTL = 0, CTL_ZERO_BYTES = 65536;
constexpr size_t WS_MOD = 1 * MiB;
constexpr size_t WS_GMOD = WS_MOD + 512 * 1024;
constexpr size_t WS_SWRAW = 2 * MiB;
constexpr size_t WS_SW = 3 * MiB;
constexpr size_t WS_SSQ = 4 * MiB;
constexpr size_t WS_GLOW = WS_SSQ + 512 * 1024;
constexpr size_t WS_WTG = WS_GLOW + 2 * MiB;
constexpr size_t WS_WTIN = 7 * MiB;
constexpr size_t WS_WTOUT = 55 * MiB;
constexpr size_t WS_TM1 = 71 * MiB;
constexpr size_t WS_TM2 = WS_TM1 + 8192;
constexpr size_t WS_TTW = WS_TM2 + 16384;
constexpr size_t WS_XG = 87 * MiB;
constexpr size_t WS_AB = 119 * MiB;
constexpr size_t WS_ZF = 183 * MiB;
constexpr size_t WS_Q = 215 * MiB;
constexpr size_t WS_K = 231 * MiB;
constexpr size_t WS_V = 247 * MiB;
constexpr size_t WS_R = 279 * MiB;
constexpr size_t WS_DEC = 311 * MiB;
constexpr size_t WS_END = 315 * MiB;
constexpr size_t WS_QIB = WS_XG, WS_KIB = WS_XG + 16 * MiB;
constexpr size_t WS_OF = WS_AB, WS_OB = WS_AB + 32 * MiB;
constexpr size_t WS_WFT = WS_AB;
constexpr size_t WS_TR = WS_AB + 2 * MiB;
constexpr size_t WS_WCT = WS_AB + 3 * MiB;
constexpr size_t WS_WU = WS_AB + 8 * MiB;
constexpr int CW_BAR = 4096;

constexpr int LDS_BYTES = 156672;
constexpr int RING_BYTES = 131072;
constexpr int MISC_OFF = 155648 + 320;

#define GAS __attribute__((address_space(1)))
#define LAS __attribute__((address_space(3)))
typedef unsigned short bf16;
typedef unsigned v4u __attribute__((ext_vector_type(4)));
typedef unsigned v2u __attribute__((ext_vector_type(2)));
typedef float f32x4 __attribute__((ext_vector_type(4)));
typedef GAS unsigned gu32;
#define LDS_WAIT() asm volatile("s_waitcnt lgkmcnt(0)" ::: "memory")
__device__ __forceinline__ unsigned f2bf(float f) { unsigned u = __builtin_bit_cast(unsigned, f); return (u + 0x7fffu + ((u >> 16) & 1u)) >> 16; }
__device__ __forceinline__ unsigned pk2(float lo, float hi) { return f2bf(lo) | (f2bf(hi) << 16); }
__device__ __forceinline__ float bflo(unsigned u) { return __builtin_bit_cast(float, u << 16); }
__device__ __forceinline__ float bfhi(unsigned u) { return __builtin_bit_cast(float, u & 0xffff0000u); }
__device__ __forceinline__ float bf2f(bf16 h) { return __builtin_bit_cast(float, (unsigned)h << 16); }
__device__ __forceinline__ float silu_f(float x) { return x / (1.f + __expf(-x)); }
__device__ __forceinline__ float logsig_f(float z) { return fminf(z, 0.f) - log1pf(__expf(-fabsf(z))); }

#define XB_TMO      128
#define XB_XCNT(j)  (256  + 64 * (j))
#define XB_XSUB(j)  (1280 + 64 * (j))
#define XB_XGEN(j)  (2304 + 64 * (j))
#define XB_TOP      3328
#define XB_TOPGEN   3392
#define XCD_BAR_WORDS 3456
#define XB_SPIN_CAP (1u << 18)
__device__ __forceinline__ unsigned xb_ld(unsigned* p)              { return __hip_atomic_load(p, __ATOMIC_RELAXED, __HIP_MEMORY_SCOPE_AGENT); }
__device__ __forceinline__ unsigned xb_add(unsigned* p, unsigned v) { return __hip_atomic_fetch_add(p, v, __ATOMIC_RELAXED, __HIP_MEMORY_SCOPE_AGENT); }
__device__ __forceinline__ unsigned xb_xcc_id() { return (unsigned)__builtin_amdgcn_s_getreg((3 << 11) | 20) & 0xFu; }
#define XB_SPIN(cond, bar) do { unsigned _sp = 0; while (cond) { __builtin_amdgcn_s_sleep(1); \
    if ((++_sp & 255u) == 0u) { if (xb_ld(&(bar)[XB_TMO])) break; if (_sp > XB_SPIN_CAP) { atomicAdd(&(bar)[XB_TMO], 1u); break; } } } } while (0)
struct XcdBarrier { unsigned* bar; unsigned x; volatile LAS unsigned* st; };
__device__ __forceinline__ XcdBarrier xcd_barrier_post(unsigned* bar, volatile LAS unsigned* st) {
    XcdBarrier b; b.bar = bar; b.x = xb_xcc_id(); b.st = st;
    if (threadIdx.x == 0) (void)xb_add(&bar[XB_XCNT(b.x)], 1u);
    return b;
}
__device__ __forceinline__ void xcd_barrier_complete(unsigned* bar, unsigned x, unsigned& nloc, unsigned& nx) {
    const unsigned G = gridDim.x * gridDim.y * gridDim.z;
    unsigned sum, cnt, mine, sp = 0u;
    for (;;) {
        sum = 0u; cnt = 0u; mine = 0u;
#pragma unroll
        for (unsigned j = 0; j < 16; ++j) { const unsigned c = xb_ld(&bar[XB_XCNT(j)]); sum += c; cnt += (c > 0u) ? 1u : 0u; mine = (j == x) ? c : mine; }
        if (sum == G) break;
        __builtin_amdgcn_s_sleep(1);
        if ((++sp & 255u) == 0u) { if (xb_ld(&bar[XB_TMO])) break; if (sp > XB_SPIN_CAP) { atomicAdd(&bar[XB_TMO], 1u); break; } }
    }
    nloc = mine > 0u ? mine : 1u; nx = cnt > 0u ? cnt : 1u;
}
__device__ __forceinline__ void xcd_barrier(const XcdBarrier& b) {
    asm volatile("s_waitcnt vmcnt(0)" ::: "memory");
    __syncthreads();
    if (threadIdx.x == 0) {
        unsigned* bar = b.bar;
        __builtin_amdgcn_s_waitcnt(0);
        unsigned nloc = b.st[0], nx = b.st[1];
        if (nloc == 0u) { xcd_barrier_complete(bar, b.x, nloc, nx); b.st[0] = nloc; b.st[1] = nx; }
        const unsigned old = xb_add(&bar[XB_XSUB(b.x)], 1u);
        const unsigned gen = old / nloc;
        if (old + 1u == (gen + 1u) * nloc) {
            __builtin_amdgcn_fence(__ATOMIC_RELEASE, "agent");
            asm volatile("s_waitcnt vmcnt(0)" ::: "memory");
            const unsigned og = xb_add(&bar[XB_TOP], 1u);
            const unsigned tg = og / nx;
            if (og + 1u == (tg + 1u) * nx) xb_add(&bar[XB_TOPGEN], 1u);
            else XB_SPIN(xb_ld(&bar[XB_TOPGEN]) == tg, bar);
            __builtin_amdgcn_fence(__ATOMIC_ACQUIRE, "agent");
            xb_add(&bar[XB_XGEN(b.x)], 1u);
            asm volatile("s_waitcnt vmcnt(0)" ::: "memory");
        } else {
            XB_SPIN(xb_ld(&bar[XB_XGEN(b.x)]) == gen, bar);
            __builtin_amdgcn_fence(__ATOMIC_ACQUIRE, "agent");
            asm volatile("s_waitcnt vmcnt(0)" ::: "memory");
        }
    }
    __syncthreads();
}

struct Args { const float* in[14]; float* out; unsigned char* ws; int ph_lo, ph_hi; };
typedef const __attribute__((address_space(4))) Args* KArgs;
struct Frame {
    LAS unsigned char* lds;
    int tid, lane, wave, vcu, G;
    KArgs ka; unsigned char* ws;
    __device__ __forceinline__ const float* in(int k) const { return ka->in[k]; }
};
#define F_x F.in(0)
#define F_c F.in(1)
#define F_norm_g F.in(2)
#define F_w_ada F.in(3)
#define F_b_ada F.in(4)
#define F_w_in F.in(5)
#define F_w_fmap F.in(6)
#define F_w_af F.in(7)
#define F_b_af F.in(8)
#define F_w_ab F.in(9)
#define F_b_ab F.in(10)
#define F_gla_g F.in(11)
#define F_w_out F.in(12)
#define F_final_g F.in(13)
__device__ __forceinline__ Frame make_frame(LAS unsigned char* lds) {
    Frame F; F.lds = lds;
    int t = threadIdx.x; asm volatile("" : "+v"(t));
    KArgs ka = (KArgs)__builtin_amdgcn_kernarg_segment_ptr(); asm volatile("" : "+s"(ka));
    F.ka = ka; F.ws = ka->ws;
    F.tid = t; F.lane = t & 63; F.wave = __builtin_amdgcn_readfirstlane(t >> 6);
    F.G = gridDim.x; { const int bx = blockIdx.x; F.vcu = (F.G % 8 == 0) ? (bx % 8) * (F.G / 8) + bx / 8 : bx; }
    return F;
}

struct EpiProj {
    static constexpr bool PERM = true, AFTER_DRAIN = false;
    const float* ssq; const float* sw;
    unsigned char* ws;
    __device__ __forceinline__ void operator()(const pg8::f32x4 (&acc)[2][2][4][2], const pg8::Unit& u, int wr, int wc, int fr, int fq) const {
        const int b = u.pm >> 3, pn = u.pn;
        bf16* dst; int ldc, dcol; int mode;
        if (pn < 4) { dst = (bf16*)(ws + WS_ZF); ldc = 1024; dcol = pn * 256; mode = 1; }
        else if (pn < 6) { dst = (bf16*)(ws + WS_Q); ldc = 512; dcol = (pn - 4) * 256; mode = 2; }
        else if (pn < 8) { dst = (bf16*)(ws + WS_K); ldc = 512; dcol = (pn - 6) * 256; mode = 0; }
        else if (pn < 12) { dst = (bf16*)(ws + WS_V); ldc = 1024; dcol = (pn - 8) * 256; mode = 0; }
        else { dst = (bf16*)(ws + WS_R); ldc = 1024; dcol = (pn - 12) * 256; mode = 1; }
        const int col0 = wc * 32 + 8 * fq;
        pg8::f32x4 bv[2][2];
#pragma unroll
        for (int bj = 0; bj < 2; ++bj)
#pragma unroll
            for (int n = 0; n < 2; ++n) bv[bj][n] = *(const pg8::f32x4*)(sw + (size_t)b * NSW + 2048 + pn * 256 + col0 + bj * 128 + 4 * n);
#pragma unroll
        for (int ai = 0; ai < 2; ++ai)
#pragma unroll
            for (int m = 0; m < 4; ++m) {
                const int row = u.pm * 256 + ai * 128 + wr * 64 + m * 16 + fr;
                const pg8::f32x4 p = *(const pg8::f32x4*)(ssq + (size_t)row * 4);
                const float rs = rsqrtf(((p[0] + p[1]) + (p[2] + p[3])) * (1.f / 1024.f) + EPS);
                bf16* rowp = dst + (size_t)row * ldc + dcol + col0;
#pragma unroll
                for (int bj = 0; bj < 2; ++bj) {
                    pg8::f32x4 v0 = acc[ai][bj][m][0] * rs + bv[bj][0], v1 = acc[ai][bj][m][1] * rs + bv[bj][1];
                    if (mode == 1) {
#pragma unroll
                        for (int j = 0; j < 4; ++j) { v0[j] = silu_f(v0[j]); v1[j] = silu_f(v1[j]); }
                    } else if (mode == 2) { v0 = v0 * 0.08838834764831845f; v1 = v1 * 0.08838834764831845f; }
                    pg8::u32x4 w; w.x = pg8::cvt_pk_bf16(v0[0], v0[1]); w.y = pg8::cvt_pk_bf16(v0[2], v0[3]); w.z = pg8::cvt_pk_bf16(v1[0], v1[1]); w.w = pg8::cvt_pk_bf16(v1[2], v1[3]);
                    *(pg8::u32x4*)(rowp + bj * 128) = w;
                }
            }
    }
};
struct EpiAB {
    static constexpr bool PERM = true, AFTER_DRAIN = false;
    const float* ssq; const float* sw; bf16* abT;
    __device__ __forceinline__ void operator()(const pg8::f32x4 (&acc)[2][2][4][2], const pg8::Unit& u, int wr, int wc, int fr, int fq) const {
        const int b = u.pn >> 3, pos0 = (u.pn & 7) * 256 + wc * 32 + 8 * fq, tok0 = u.pn * 256 + wc * 32 + 8 * fq;
        pg8::f32x4 rs[2][2];
#pragma unroll
        for (int bj = 0; bj < 2; ++bj)
#pragma unroll
            for (int n = 0; n < 2; ++n)
#pragma unroll
                for (int j = 0; j < 4; ++j) {
                    const pg8::f32x4 p = *(const pg8::f32x4*)(ssq + (size_t)(tok0 + bj * 128 + 4 * n + j) * 4);
                    rs[bj][n][j] = rsqrtf(((p[0] + p[1]) + (p[2] + p[3])) * (1.f / 1024.f) + EPS);
                }
#pragma unroll
        for (int ai = 0; ai < 2; ++ai)
#pragma unroll
            for (int m = 0; m < 4; ++m) {
                const int np = u.pm * 256 + ai * 128 + wr * 64 + m * 16 + fr;
                const float bias = sw[(size_t)b * NSW + np];
                bf16* rowp = abT + ((size_t)(b * 1024 + (np & 1023)) * 4096 + (size_t)(np >> 10) * 2048 + pos0);
#pragma unroll
                for (int bj = 0; bj < 2; ++bj) {
                    const pg8::f32x4 v0 = acc[ai][bj][m][0] * rs[bj][0] + bias, v1 = acc[ai][bj][m][1] * rs[bj][1] + bias;
                    pg8::u32x4 w; w.x = pg8::cvt_pk_bf16(v0[0], v0[1]); w.y = pg8::cvt_pk_bf16(v0[2], v0[3]); w.z = pg8::cvt_pk_bf16(v1[0], v1[1]); w.w = pg8::cvt_pk_bf16(v1[2], v1[3]);
                    *(pg8::u32x4*)(rowp + bj * 128) = w;
                }
            }
    }
};
struct EpiDft {
    static constexpr bool PERM = true, AFTER_DRAIN = false;
    bf16* zf;
    __device__ __forceinline__ void operator()(const pg8::f32x4 (&acc)[2][2][4][2], const pg8::Unit& u, int wr, int wc, int fr, int fq) const {
        const int col0 = u.pn * 256 + wc * 32 + 8 * fq;
#pragma unroll
        for (int ai = 0; ai < 2; ++ai)
#pragma unroll
            for (int m = 0; m < 4; ++m) {
                const int tok = u.bz * 2048 + u.pm * 256 + ai * 128 + wr * 64 + m * 16 + fr;
                bf16* rowp = zf + (size_t)tok * 1024 + col0;
#pragma unroll
                for (int bj = 0; bj < 2; ++bj) {
                    const pg8::u32x4 z = *(const pg8::u32x4*)(rowp + bj * 128);
                    const pg8::f32x4 a0 = acc[ai][bj][m][0], a1 = acc[ai][bj][m][1];
                    pg8::u32x4 w;
                    w.x = pg8::cvt_pk_bf16(a0[0] * bflo(z.x), a0[1] * bfhi(z.x)); w.y = pg8::cvt_pk_bf16(a0[2] * bflo(z.y), a0[3] * bfhi(z.y));
                    w.z = pg8::cvt_pk_bf16(a1[0] * bflo(z.z), a1[1] * bfhi(z.z)); w.w = pg8::cvt_pk_bf16(a1[2] * bflo(z.w), a1[3] * bfhi(z.w));
                    *(pg8::u32x4*)(rowp + bj * 128) = w;
                }
            }
    }
};
struct EpiOut {
    static constexpr bool PERM = false, AFTER_DRAIN = true;
    const float* xin; float* xout; bf16* xg; float* ssq; const float* gate; const float* gmodn;
    __device__ __forceinline__ void fused(pg8::f32x4 (&acc)[2][2][4][2], const pg8::Unit& u, int wr, int wc, int fr, int fq, PG8_LAS unsigned char* lds, int wid, int lane) const {
        const int b = u.pm >> 3, col0 = u.pn * 256 + wc * 32 + 4 * fq;
        PG8_LAS float* P = (PG8_LAS float*)lds;
        pg8::f32x4 gt[2][2], gm[2][2];
#pragma unroll
        for (int bj = 0; bj < 2; ++bj)
#pragma unroll
            for (int n = 0; n < 2; ++n) {
                gt[bj][n] = *(const pg8::f32x4*)(gate + (size_t)b * 3072 + col0 + bj * 128 + n * 16);
                gm[bj][n] = gmodn ? *(const pg8::f32x4*)(gmodn + (size_t)b * 1024 + col0 + bj * 128 + n * 16) : (pg8::f32x4){0.f, 0.f, 0.f, 0.f};
            }
#pragma unroll
        for (int ai = 0; ai < 2; ++ai)
#pragma unroll
            for (int m = 0; m < 4; ++m) {
                const int rl = ai * 128 + wr * 64 + m * 16 + fr; const size_t off = (size_t)(u.pm * 256 + rl) * 1024 + col0;
                float s = 0.f;
#pragma unroll
                for (int bj = 0; bj < 2; ++bj)
#pragma unroll
                    for (int n = 0; n < 2; ++n) {
                        const pg8::f32x4 xv = *(const pg8::f32x4*)(xin + off + bj * 128 + n * 16);
                        const pg8::f32x4 o = xv + gt[bj][n] * acc[ai][bj][m][n];
                        *(pg8::f32x4*)(xout + off + bj * 128 + n * 16) = o;
                        s += (o[0] * o[0] + o[1] * o[1]) + (o[2] * o[2] + o[3] * o[3]);
                        if (gmodn) { const pg8::f32x4 h = o * gm[bj][n]; pg8::u32x2 w; w.x = pg8::cvt_pk_bf16(h[0], h[1]); w.y = pg8::cvt_pk_bf16(h[2], h[3]); *(pg8::u32x2*)(xg + off + bj * 128 + n * 16) = w; }
                    }
                s += __shfl_xor(s, 16); s += __shfl_xor(s, 32);
                if (fq == 0) P[rl * 4 + wc] = s;
            }
        asm volatile("s_waitcnt lgkmcnt(0)" ::: "memory"); __builtin_amdgcn_s_barrier(); asm volatile("" ::: "memory");
        const int t = wid * 64 + lane;
        if (t < 256) { const float s = (P[t * 4 + 0] + P[t * 4 + 1]) + (P[t * 4 + 2] + P[t * 4 + 3]); ssq[(size_t)(u.pm * 256 + t) * 4 + u.pn] = s; }
    }
};

struct EpiStore {
    static constexpr bool PERM = true, AFTER_DRAIN = false;
    bf16* O; int ldc;
    __device__ __forceinline__ void operator()(const pg8::f32x4 (&acc)[2][2][4][2], const pg8::Unit& u, int wr, int wc, int fr, int fq) const {
        bf16* base = O + (size_t)u.coff + u.pn * 256 + wc * 32 + 8 * fq;
#pragma unroll
        for (int ai = 0; ai < 2; ++ai)
#pragma unroll
            for (int m = 0; m < 4; ++m) { bf16* rowp = base + (size_t)(u.pm * 256 + ai * 128 + wr * 64 + m * 16 + fr) * ldc;
#pragma unroll
                for (int bj = 0; bj < 2; ++bj) { const pg8::f32x4 v0 = acc[ai][bj][m][0], v1 = acc[ai][bj][m][1];
                    pg8::u32x4 w; w.x = pg8::cvt_pk_bf16(v0[0], v0[1]); w.y = pg8::cvt_pk_bf16(v0[2], v0[3]); w.z = pg8::cvt_pk_bf16(v1[0], v1[1]); w.w = pg8::cvt_pk_bf16(v1[2], v1[3]);
                    *(pg8::u32x4*)(rowp + bj * 128) = w; } }
    }
};

__device__ __forceinline__ void smallm_item(const Frame& F, const float* W, int ldw, int n0, int ncols, const float* bias, float* out, int ldo, LAS float* sv, LAS float* red) {
    const int cg = F.lane & 15, kq = F.lane >> 4, w = F.wave;
    float acc[8][4];
#pragma unroll
    for (int b = 0; b < 8; ++b)
#pragma unroll
        for (int j = 0; j < 4; ++j) acc[b][j] = 0.f;
    const bool ok = (n0 + 4 * cg) < ncols;
    const float* wp = W + (size_t)(128 * w + kq) * ldw + n0 + 4 * cg;
#pragma unroll 4
    for (int s = 0; s < 32; ++s) {
        const int k = 128 * w + 4 * s + kq;
        f32x4 wv = (f32x4){0.f, 0.f, 0.f, 0.f};
        if (ok) wv = *(const f32x4*)(wp + (size_t)(4 * s) * ldw);
        const f32x4 s0 = *(const LAS f32x4*)(sv + k * 8), s1 = *(const LAS f32x4*)(sv + k * 8 + 4);
#pragma unroll
        for (int j = 0; j < 4; ++j) {
            acc[0][j] += s0[0] * wv[j]; acc[1][j] += s0[1] * wv[j]; acc[2][j] += s0[2] * wv[j]; acc[3][j] += s0[3] * wv[j];
            acc[4][j] += s1[0] * wv[j]; acc[5][j] += s1[1] * wv[j]; acc[6][j] += s1[2] * wv[j]; acc[7][j] += s1[3] * wv[j];
        }
    }
#pragma unroll
    for (int b = 0; b < 8; ++b)
#pragma unroll
        for (int j = 0; j < 4; ++j) { float v = acc[b][j]; v += __shfl_xor(v, 16); v += __shfl_xor(v, 32); acc[b][j] = v; }
    if (kq == 0) {
#pragma unroll
        for (int b = 0; b < 8; ++b) *(LAS f32x4*)(red + (w * 8 + b) * 64 + 4 * cg) = (f32x4){acc[b][0], acc[b][1], acc[b][2], acc[b][3]};
    }
    __syncthreads();
    { const int b = F.tid >> 6, c = F.tid & 63; float s = 0.f;
#pragma unroll
      for (int ww = 0; ww < 8; ++ww) s += red[(ww * 8 + b) * 64 + c];
      if (n0 + c < ncols) out[(size_t)b * ldo + n0 + c] = s + (bias ? bias[n0 + c] : 0.f); }
    __syncthreads();
}
__device__ __forceinline__ void transpose_item(const float* W, int ldw, bf16* WT, int ldo, LAS float* scr, int lane) {
#pragma unroll 8
    for (int i = 0; i < 32; ++i) { const int kk = 2 * i + (lane >> 5); scr[kk * 33 + (lane & 31)] = W[(size_t)kk * ldw + (lane & 31)]; }
    LDS_WAIT(); asm volatile("" ::: "memory");
    const int c = lane & 7;
#pragma unroll
    for (int j = 0; j < 4; ++j) { const int n = (lane >> 3) + 8 * j; const LAS float* s = scr + (8 * c) * 33 + n;
        v4u o; o.x = pk2(s[0 * 33], s[1 * 33]); o.y = pk2(s[2 * 33], s[3 * 33]); o.z = pk2(s[4 * 33], s[5 * 33]); o.w = pk2(s[6 * 33], s[7 * 33]);
        *(GAS v4u*)(WT + (size_t)n * ldo + 8 * c) = o; }
    LDS_WAIT(); asm volatile("" ::: "memory");
}

__device__ __forceinline__ void phase_p0(const Frame& F) {
    LAS float* sv = (LAS float*)F.lds;
    LAS float* red = (LAS float*)(F.lds + 32768);
    for (int e = F.tid; e < 8192; e += NTHR) { const int k = e >> 3, b = e & 7; sv[e] = silu_f(F_c[b * 1024 + k]); }
    __syncthreads();
    float* mod = (float*)(F.ws + WS_MOD);
    for (int it = F.vcu; it < 4 * 48; it += F.G) { const int l = it / 48, ch = it % 48;
        smallm_item(F, F_w_ada + (size_t)l * 1024 * 3072, 3072, ch * 64, 3072, F_b_ada + l * 3072, mod + (size_t)l * 8 * 3072, 3072, sv, red); }
    __syncthreads();
    LAS float* scr = (LAS float*)(F.lds + F.wave * 16384);
    const int gw = F.vcu * NWAVES + F.wave, NGW = F.G * NWAVES;
    constexpr int I_IN = 16 * 129, I_OUT = 32 * 32, I_L = I_IN + I_OUT;
    bf16* wtin = (bf16*)(F.ws + WS_WTIN); bf16* wtg = (bf16*)(F.ws + WS_WTG); bf16* wtout = (bf16*)(F.ws + WS_WTOUT);
    for (int it = gw; it < 4 * I_L; it += NGW) {
        const int l = it / I_L; int r = it % I_L;
        if (r < I_IN) { const int kb = r / 129, nb = r % 129; const float* W = F_w_in + (size_t)l * 1024 * DIN + (size_t)(64 * kb) * DIN + 1024 + 32 * nb;
            bf16* WT = (nb < 128) ? wtin + ((size_t)l * NPJ + 2048 + 32 * nb) * 1024 + 64 * kb : wtg + ((size_t)l * 32) * 1024 + 64 * kb;
            transpose_item(W, DIN, WT, 1024, scr, F.lane); }
        else { r -= I_IN; const int kb = r / 32, nb = r % 32; const float* W = F_w_out + (size_t)l * 2048 * 1024 + (size_t)(64 * kb) * 1024 + 32 * nb;
            transpose_item(W, 1024, wtout + ((size_t)l * 1024 + 32 * nb) * 2048 + 64 * kb, 2048, scr, F.lane); }
    }
    { bf16* wft = (bf16*)(F.ws + WS_WFT);
      for (int it = gw; it < 16 * 32; it += NGW) { const int lg = it >> 5, kb = (it >> 3) & 3, nb = it & 7;
          transpose_item(F_w_fmap + (size_t)lg * 65536 + (size_t)(64 * kb) * 256 + 32 * nb, 256, wft + (size_t)lg * 65536 + (size_t)(32 * nb) * 256 + 64 * kb, 256, scr, F.lane); } }
    const int gt = F.vcu * NTHR + F.tid, NGT = F.G * NTHR;
    { bf16* wu = (bf16*)(F.ws + WS_WU);
      for (int e = gt; e < 4 * 1024 * 128; e += NGT) { const int c8 = e & 127, lk = e >> 7; const float* src = F_w_in + (size_t)lk * DIN + 8 * c8;
          const f32x4 a = *(const f32x4*)src, b = *(const f32x4*)(src + 4); v4u w; w.x = pk2(a[0], a[1]); w.y = pk2(a[2], a[3]); w.z = pk2(b[0], b[1]); w.w = pk2(b[2], b[3]);
          *(v4u*)(wu + (size_t)lk * 1024 + 8 * c8) = w; } }
    { unsigned* tr = (unsigned*)(F.ws + WS_TR);
      for (int e = gt; e < 2 * 256 * 128; e += NGT) { const int c2 = (e & 127) * 2, c = (e >> 7) & 255, part = e >> 15; float v[2];
#pragma unroll
          for (int j = 0; j < 2; ++j) { float sn, cs; sincospif((float)((c * (c2 + j)) & 255) * (1.f / 128.f), &sn, &cs); v[j] = (part ? sn : cs) * 0.0625f; }
          tr[e] = pk2(v[0], v[1]); } }
    { bf16* t1 = (bf16*)(F.ws + WS_TM1); bf16* t2 = (bf16*)(F.ws + WS_TM2); unsigned* tw = (unsigned*)(F.ws + WS_TTW);
      for (int e = gt; e < 4096; e += NGT) { const int el = e & 7, ln = (e >> 3) & 63, s4 = (e >> 9) & 3, ri = e >> 11; const int k1 = ln & 31, hh = ln >> 5, p = s4 >> 1, l1 = 16 * (s4 & 1) + 8 * hh + el;
          float sn, cs; sincospif((float)((k1 * l1) & 31) * (1.f / 16.f), &sn, &cs); const float v = ri == 0 ? (p == 0 ? cs : -sn) : (p == 0 ? -sn : -cs); t1[e] = (bf16)f2bf(v); }
      for (int e = gt; e < 8192; e += NGT) { const int el = e & 7, ln = (e >> 3) & 63, sp = (e >> 9) & 1, mt = (e >> 10) & 1, ri = (e >> 11) & 1, mk = e >> 12; const int k2 = 32 * mk + (ln & 31), hh = ln >> 5, l2 = 32 * mt + 16 * sp + 8 * (el >> 2) + 4 * hh + (el & 3);
          float sn, cs; sincospif((float)((k2 * l2) & 63) * (1.f / 32.f), &sn, &cs); t2[e] = (bf16)f2bf((ri == 0 ? cs : sn) * 0.02209708691207961f); }
      for (int e = gt; e < 2048; e += NGT) { const int r3 = e & 3, ln = (e >> 2) & 63, g = (e >> 8) & 3, mt = e >> 10; const int r = 4 * g + r3, l2 = 32 * mt + (r & 3) + 8 * (r >> 2) + 4 * (ln >> 5), k1 = ln & 31;
          float sn, cs; sincospif((float)((l2 * k1) & 2047) * (1.f / 1024.f), &sn, &cs); tw[e] = pk2(cs, sn); } }
}

__device__ __forceinline__ void phase_p1(const Frame& F) {
    const float* mod = (const float*)(F.ws + WS_MOD);
    float* gmod = (float*)(F.ws + WS_GMOD);
    const int gt = F.vcu * NTHR + F.tid, NGT = F.G * NTHR;
    for (int e = gt; e < 4 * 8 * 1024; e += NGT) { const int l = e >> 13, b = (e >> 10) & 7, k = e & 1023; gmod[e] = F_norm_g[l * 1024 + k] * (1.f + mod[((size_t)l * 8 + b) * 3072 + 1024 + k]); }
    const int gw = F.vcu * NWAVES + F.wave, NGW = F.G * NWAVES;
    bf16* xg = (bf16*)(F.ws + WS_XG); float* ssq = (float*)(F.ws + WS_SSQ);
    for (int row = gw; row < MTOK; row += NGW) { const int b = row >> 11; float s = 0.f;
#pragma unroll
        for (int j = 0; j < 4; ++j) { const int k = 4 * F.lane + 256 * j; const f32x4 xv = *(const f32x4*)(F_x + (size_t)row * 1024 + k);
            const f32x4 ng = *(const f32x4*)(F_norm_g + k); const f32x4 sc = *(const f32x4*)(mod + (size_t)b * 3072 + 1024 + k);
            s += (xv[0] * xv[0] + xv[1] * xv[1]) + (xv[2] * xv[2] + xv[3] * xv[3]);
            const f32x4 h = xv * (ng * (sc + 1.f)); v2u w; w.x = pk2(h[0], h[1]); w.y = pk2(h[2], h[3]); *(v2u*)(xg + (size_t)row * 1024 + k) = w; }
#pragma unroll
        for (int o = 1; o < 64; o <<= 1) s += __shfl_xor(s, o);
        if (F.lane == 0) *(f32x4*)(ssq + (size_t)row * 4) = (f32x4){s, 0.f, 0.f, 0.f}; }
    LAS float* sv = (LAS float*)F.lds; LAS float* red = (LAS float*)(F.lds + 32768);
    float* swraw = (float*)(F.ws + WS_SWRAW);
    int curl = -1;
    for (int it = F.vcu; it < 4 * 81; it += F.G) { const int l = it / 81, ch = it % 81;
        if (l != curl) { __syncthreads(); for (int e = F.tid; e < 8192; e += NTHR) { const int k = e >> 3, b = e & 7; sv[e] = mod[((size_t)l * 8 + b) * 3072 + k]; } __syncthreads(); curl = l; }
        smallm_item(F, F_w_in + (size_t)l * 1024 * DIN, DIN, ch * 64, DIN, nullptr, swraw + (size_t)l * 8 * DIN, DIN, sv, red); }
    __syncthreads();
}

__device__ __forceinline__ void phase_p2(const Frame& F) {
    const bf16* wct = (const bf16*)(F.ws + WS_WCT);
    const float* swraw = (const float*)(F.ws + WS_SWRAW); float* sw = (float*)(F.ws + WS_SW);
    const int gw = F.vcu * NWAVES + F.wave, NGW = F.G * NWAVES;
    for (int it = gw; it < 4 * 2048; it += NGW) { const int l = it >> 11, np = it & 2047, part = np >> 10, g = (np >> 8) & 3, d = np & 255, z = (l * 4 + g) * 2 + part;
        const v2u w4 = *(const v2u*)(wct + ((size_t)z * 256 + d) * 256 + 4 * F.lane);
        const float w0 = bflo(w4.x), w1 = bfhi(w4.x), w2 = bflo(w4.y), w3 = bfhi(w4.y);
        float mine = 0.f;
#pragma unroll
        for (int b = 0; b < 8; ++b) { const f32x4 su = *(const f32x4*)(swraw + (size_t)(l * 8 + b) * DIN + g * 256 + 4 * F.lane); float sacc = su[0] * w0 + su[1] * w1 + su[2] * w2 + su[3] * w3;
#pragma unroll
            for (int o = 1; o < 64; o <<= 1) sacc += __shfl_xor(sacc, o);
            mine = (F.lane == b) ? sacc : mine; }
        if (F.lane < 8) sw[(size_t)(l * 8 + F.lane) * NSW + np] = mine; }
    const int gt = F.vcu * NTHR + F.tid, NGT = F.G * NTHR;
    for (int e = gt; e < 4 * 8 * (NSW - 2048); e += NGT) { const int r = e % (NSW - 2048), lb = e / (NSW - 2048), np = 2048 + r;
        sw[(size_t)lb * NSW + np] = (np < NPJ) ? swraw[(size_t)lb * DIN + np - 1024] : swraw[(size_t)lb * DIN + 5120 + (np - NPJ)]; }
}

__device__ __forceinline__ void gate_rows(const Frame& F, int l) {
    const bf16* xg = (const bf16*)(F.ws + WS_XG); const bf16* wtg = (const bf16*)(F.ws + WS_WTG) + (size_t)l * 32 * 1024;
    const float* ssq = (const float*)(F.ws + WS_SSQ); const float* sw = (const float*)(F.ws + WS_SW) + (size_t)l * 8 * NSW; float* glow = (float*)(F.ws + WS_GLOW);
    const int mt = F.wave >> 1, nt = F.wave & 1, fr = F.lane & 15, fq = F.lane >> 4;
    for (int it = F.vcu; it < MTOK / 64; it += F.G) {
        const int row0 = it * 64 + 16 * mt;
        const bf16* ap = xg + (size_t)(row0 + fr) * 1024 + 8 * fq; const bf16* bp = wtg + (size_t)(16 * nt + fr) * 1024 + 8 * fq;
        pg8::f32x4 acc = {0.f, 0.f, 0.f, 0.f};
#pragma unroll 8
        for (int ks = 0; ks < 32; ++ks) { const pg8::bf16x8 a = *(const pg8::bf16x8*)(ap + 32 * ks), b = *(const pg8::bf16x8*)(bp + 32 * ks);
            acc = __builtin_amdgcn_mfma_f32_16x16x32_bf16(a, b, acc, 0, 0, 0); }
        const float bias = sw[(size_t)(row0 >> 11) * NSW + NPJ + 16 * nt + fr];
#pragma unroll
        for (int r = 0; r < 4; ++r) { const int row = row0 + 4 * fq + r; const f32x4 p = *(const f32x4*)(ssq + (size_t)row * 4); const float rs = rsqrtf(((p[0] + p[1]) + (p[2] + p[3])) * (1.f / 1024.f) + EPS);
            glow[(size_t)row * 32 + 16 * nt + fr] = acc[r] * rs + bias; }
    }
}

__host__ __device__ __forceinline__ unsigned off_b(unsigned row, unsigned ch) { return 256u * row + 16u * (ch ^ (((row & 3) << 2) | ((row >> 2) & 3))); }
__host__ __device__ __forceinline__ unsigned off_v(unsigned row, unsigned ch) { return 1024u * (row >> 3) + 512u * (ch >> 2) + 64u * (row & 7) + 16u * ((ch & 3) ^ ((row >> 2) & 3)); }
__device__ __forceinline__ void fourier_ct(const Frame& F) {
    typedef float f32x16 __attribute__((ext_vector_type(16)));
    typedef float f32x8 __attribute__((ext_vector_type(8)));
    typedef short s16x8 __attribute__((ext_vector_type(8)));
    typedef short s16x4 __attribute__((ext_vector_type(4)));
    typedef __bf16 b16x8 __attribute__((ext_vector_type(8)));
    const bf16* abT = (const bf16*)(F.ws + WS_AB); bf16* zf = (bf16*)(F.ws + WS_ZF);
    LAS unsigned char* M2L = F.lds + 131072; LAS unsigned char* TWL = F.lds + 147456;
    const int lane = F.lane, hh = lane >> 5, blk = (lane >> 4) & 1, q4 = (lane & 15) >> 2, p4 = lane & 3;
    for (int e = F.tid; e < 1536; e += NTHR) *(LAS v4u*)(M2L + e * 16) = *(const v4u*)(F.ws + WS_TM2 + (size_t)e * 16);
    s16x8 m1[2][4];
#pragma unroll
    for (int ri = 0; ri < 2; ++ri)
#pragma unroll
        for (int s4 = 0; s4 < 4; ++s4) m1[ri][s4] = *(const s16x8*)(F.ws + WS_TM1 + (size_t)(((ri * 4 + s4) * 64 + lane) * 16));
    __syncthreads();
    for (int it = F.vcu; it < 256; it += F.G) {
        const int b = it >> 5, cb = it & 31;
        const bf16* colbase = abT + (size_t)(b * 1024 + cb * 32 + 4 * F.wave) * 4096;
        LAS unsigned char* slot0 = F.lds + F.wave * 16384;
        unsigned soff[8];
#pragma unroll
        for (int i = 0; i < 8; ++i) { const int p = i >> 2, rowlo = (lane >> 2) & 7, l1 = 8 * (i & 3) + rowlo, ch = 4 * (lane >> 5) + ((lane & 3) ^ ((((i & 3) & 1) << 1) | (rowlo >> 2))); soff[i] = (unsigned)(p * 2048 + l1 * 64 + ch * 8); }
#define CT_ISSUE(j, buf) do { _Pragma("unroll") for (int i_ = 0; i_ < 8; ++i_) \
        __builtin_amdgcn_global_load_lds((const unsigned*)(colbase + (size_t)(j) * 4096 + soff[i_]), (LAS unsigned*)(slot0 + (buf) * 8192 + i_ * 1024), 16, 0, 0); } while (0)
        CT_ISSUE(0, 0); CT_ISSUE(1, 1);
        unsigned outp[2][2][16];
        float hold[2][16];
#pragma unroll
        for (int j = 0; j < 4; ++j) {
            if (j < 3) asm volatile("s_waitcnt vmcnt(8)" ::: "memory"); else asm volatile("s_waitcnt vmcnt(0)" ::: "memory");
            LAS unsigned char* slot = slot0 + (j & 1) * 8192;
            f32x16 acc[2][2];
#pragma unroll
            for (int mt = 0; mt < 2; ++mt)
#pragma unroll
                for (int ri = 0; ri < 2; ++ri)
#pragma unroll
                    for (int r = 0; r < 16; ++r) acc[mt][ri][r] = 0.f;
#pragma unroll
            for (int s4 = 0; s4 < 4; ++s4)
#pragma unroll
                for (int mt = 0; mt < 2; ++mt) {
                    LAS unsigned char* tb = slot + (s4 >> 1) * 4096;
                    const int r0 = 16 * (s4 & 1) + 8 * hh + q4, chn = 4 * mt + 2 * blk + (p4 >> 1);
                    const s16x4 lo = __builtin_amdgcn_ds_read_tr16_b64_v4i16((LAS s16x4*)(tb + off_v(r0, chn) + 8 * (p4 & 1))), hi = __builtin_amdgcn_ds_read_tr16_b64_v4i16((LAS s16x4*)(tb + off_v(r0 + 4, chn) + 8 * (p4 & 1)));
                    const s16x8 a = __builtin_shufflevector(lo, hi, 0, 1, 2, 3, 4, 5, 6, 7);
                    acc[mt][0] = __builtin_amdgcn_mfma_f32_32x32x16_bf16(a, m1[0][s4], acc[mt][0], 0, 0, 0);
                    acc[mt][1] = __builtin_amdgcn_mfma_f32_32x32x16_bf16(a, m1[1][s4], acc[mt][1], 0, 0, 0);
                }
            asm volatile("" ::: "memory");
            if (j + 2 < 4) CT_ISSUE(j + 2, j & 1);
            s16x8 yp[2][2][2];
#pragma unroll
            for (int mt = 0; mt < 2; ++mt) {
                f32x16 yr, yi;
#pragma unroll
                for (int g = 0; g < 4; ++g) { const v4u t4 = *(const LAS v4u*)(TWL + ((mt * 4 + g) * 64 + lane) * 16); const unsigned tt[4] = {t4.x, t4.y, t4.z, t4.w};
#pragma unroll
                    for (int r3 = 0; r3 < 4; ++r3) { const int r = 4 * g + r3; const float c = bflo(tt[r3]), sn = bfhi(tt[r3]); const float a0 = acc[mt][0][r], a1 = acc[mt][1][r];
                        yr[r] = a0 * c + a1 * sn; yi[r] = a1 * c - a0 * sn; } }
#pragma unroll
                for (int sp = 0; sp < 2; ++sp) {
                    const f32x8 v0 = {yr[8 * sp], yr[8 * sp + 1], yr[8 * sp + 2], yr[8 * sp + 3], yr[8 * sp + 4], yr[8 * sp + 5], yr[8 * sp + 6], yr[8 * sp + 7]};
                    const f32x8 v1 = {yi[8 * sp], yi[8 * sp + 1], yi[8 * sp + 2], yi[8 * sp + 3], yi[8 * sp + 4], yi[8 * sp + 5], yi[8 * sp + 6], yi[8 * sp + 7]};
                    yp[0][mt][sp] = __builtin_bit_cast(s16x8, __builtin_convertvector(v0, b16x8)); yp[1][mt][sp] = __builtin_bit_cast(s16x8, __builtin_convertvector(v1, b16x8)); }
            }
#pragma unroll
            for (int mk = 0; mk < 2; ++mk) {
                f32x16 a2;
#pragma unroll
                for (int r = 0; r < 16; ++r) a2[r] = 0.f;
#pragma unroll
                for (int ri = 0; ri < 2; ++ri)
#pragma unroll
                    for (int mt = 0; mt < 2; ++mt)
#pragma unroll
                        for (int sp = 0; sp < 2; ++sp) { const s16x8 mm = *(const LAS s16x8*)(M2L + ((((mk * 2 + ri) * 2 + mt) * 2 + sp) * 64 + lane) * 16);
                            a2 = __builtin_amdgcn_mfma_f32_32x32x16_bf16(mm, yp[ri][mt][sp], a2, 0, 0, 0); }
                if ((j & 1) == 0) {
#pragma unroll
                    for (int r = 0; r < 16; ++r) hold[mk][r] = a2[r];
                } else {
#pragma unroll
                    for (int r = 0; r < 16; ++r) outp[j >> 1][mk][r] = pg8::cvt_pk_bf16(hold[mk][r], a2[r]);
                }
            }
        }
#undef CT_ISSUE
        __syncthreads();
#pragma unroll
        for (int mk = 0; mk < 2; ++mk)
#pragma unroll
            for (int r = 0; r < 16; ++r) { const int lp = (lane & 31) + 32 * (32 * mk + (r & 3) + 8 * (r >> 2) + 4 * hh);
                v2u w; w.x = outp[0][mk][r]; w.y = outp[1][mk][r];
                *(LAS v2u*)(F.lds + lp * 64 + 8 * (F.wave ^ (lp & 7))) = w; }
        __syncthreads();
#pragma unroll 4
        for (int i = 0; i < 16; ++i) { const int e = F.tid + 512 * i, q = e & 3, lp = e >> 2;
            const v4u o = *(const LAS v4u*)(F.lds + lp * 64 + 16 * (q ^ ((lp & 7) >> 1)));
            const unsigned o0 = (lp & 1) ? o.z : o.x, o1 = (lp & 1) ? o.w : o.y, o2 = (lp & 1) ? o.x : o.z, o3 = (lp & 1) ? o.y : o.w;
            bf16* zp = zf + (size_t)(b * 2048 + lp) * 1024 + cb * 32 + 8 * q; const v4u z = *(const v4u*)zp;
            v4u w; w.x = pk2(bflo(o0) * bflo(z.x), bfhi(o0) * bfhi(z.x)); w.y = pk2(bflo(o1) * bflo(z.y), bfhi(o1) * bfhi(z.y));
            w.z = pk2(bflo(o2) * bflo(z.z), bfhi(o2) * bfhi(z.z)); w.w = pk2(bflo(o3) * bflo(z.w), bfhi(o3) * bfhi(z.w));
            *(v4u*)zp = w; }
        __syncthreads();
    }
}

typedef float f32x16 __attribute__((ext_vector_type(16)));
typedef float f32x8 __attribute__((ext_vector_type(8)));
typedef short s16x8 __attribute__((ext_vector_type(8)));
typedef short s16x4 __attribute__((ext_vector_type(4)));
typedef __bf16 b16x8 __attribute__((ext_vector_type(8)));
__device__ __forceinline__ s16x4 tr_rd(LAS unsigned char* p) { return __builtin_amdgcn_ds_read_tr16_b64_v4i16((LAS s16x4*)p); }
__device__ __forceinline__ s16x8 cat8(s16x4 a, s16x4 b) { return __builtin_shufflevector(a, b, 0, 1, 2, 3, 4, 5, 6, 7); }
__device__ __forceinline__ s16x8 pack8(float a0, float a1, float a2, float a3, float a4, float a5, float a6, float a7) {
    const f32x8 v = {a0, a1, a2, a3, a4, a5, a6, a7}; return __builtin_bit_cast(s16x8, __builtin_convertvector(v, b16x8)); }
#define PACK_STEP(x, s) pack8(x[8 * (s)], x[8 * (s) + 1], x[8 * (s) + 2], x[8 * (s) + 3], x[8 * (s) + 4], x[8 * (s) + 5], x[8 * (s) + 6], x[8 * (s) + 7])
#define MFMA32(a, b, c) __builtin_amdgcn_mfma_f32_32x32x16_bf16((a), (b), (c), 0, 0, 0)

__device__ __forceinline__ void gla_prep(const Frame& F, int l) {
    bf16* Q = (bf16*)(F.ws + WS_Q); bf16* Kb = (bf16*)(F.ws + WS_K); bf16* QB = (bf16*)(F.ws + WS_QIB); bf16* KB2 = (bf16*)(F.ws + WS_KIB);
    const float* glow = (const float*)(F.ws + WS_GLOW); float* DEC = (float*)(F.ws + WS_DEC);
    LAS float* gl = (LAS float*)F.lds;
    LAS float* cumL = (LAS float*)(F.lds + 8192);
    for (int it = F.vcu; it < 8 * 4 * 32; it += F.G) {
        const int ch = it & 31, h = (it >> 5) & 3, b = it >> 7; const int tok0 = b * 2048 + ch * 64;
        __syncthreads();
        *(LAS f32x4*)(gl + F.tid * 4) = *(const f32x4*)(glow + (size_t)tok0 * 32 + F.tid * 4);
        __syncthreads();
        { const int d = F.tid & 127, half = (F.tid >> 7) & 1, dir = F.tid >> 8;
          const float* wa = (dir ? F_w_ab : F_w_af) + (size_t)l * 16 * 512 + h * 128 + d; const float bias = (dir ? F_b_ab : F_b_af)[l * 512 + h * 128 + d];
          float w[16];
#pragma unroll
          for (int r = 0; r < 16; ++r) w[r] = wa[r * 512];
          float run = 0.f;
          for (int ii = 0; ii < 32; ++ii) { const int i = half * 32 + ii, pos = dir ? 63 - i : i; float z = bias;
#pragma unroll
              for (int r4 = 0; r4 < 4; ++r4) { const f32x4 g = *(const LAS f32x4*)(gl + pos * 32 + dir * 16 + 4 * r4); z += g[0] * w[4 * r4] + g[1] * w[4 * r4 + 1] + g[2] * w[4 * r4 + 2] + g[3] * w[4 * r4 + 3]; }
              run += logsig_f(z) * 0.0625f; cumL[(dir * 64 + i) * 128 + d] = run; } }
        __syncthreads();
        if (F.tid < 256) { const int d = F.tid & 127, dir = F.tid >> 7; const float t0 = cumL[(dir * 64 + 31) * 128 + d]; const float ref = cumL[(dir * 64 + 32) * 128 + d] + t0, last = cumL[(dir * 64 + 63) * 128 + d] + t0;
            float* dp = DEC + ((size_t)(((b * 4 + h) * 2 + dir) * 32 + (dir ? 31 - ch : ch))) * 384 + d;
            dp[0] = __expf(ref); dp[128] = __expf(last); dp[256] = __expf(last - ref); }
#pragma unroll
        for (int k = 0; k < 2; ++k) { const int g = F.tid + 512 * k, pos = g >> 4, dg = g & 15; const size_t go = (size_t)(tok0 + pos) * 512 + h * 128 + 8 * dg;
            const v4u q8 = *(const v4u*)(Q + go), k8 = *(const v4u*)(Kb + go);
            float qf[8] = {bflo(q8.x), bfhi(q8.x), bflo(q8.y), bfhi(q8.y), bflo(q8.z), bfhi(q8.z), bflo(q8.w), bfhi(q8.w)};
            float kf[8] = {bflo(k8.x), bfhi(k8.x), bflo(k8.y), bfhi(k8.y), bflo(k8.z), bfhi(k8.z), bflo(k8.w), bfhi(k8.w)};
#pragma unroll
            for (int dir = 0; dir < 2; ++dir) { const int i = dir ? 63 - pos : pos; const LAS float* cb = cumL + dir * 64 * 128 + 8 * dg;
                float qo[8], ko[8];
#pragma unroll
                for (int j4 = 0; j4 < 2; ++j4) { const f32x4 ci = *(const LAS f32x4*)(cb + i * 128 + 4 * j4), c32 = *(const LAS f32x4*)(cb + 32 * 128 + 4 * j4), c31 = *(const LAS f32x4*)(cb + 31 * 128 + 4 * j4);
#pragma unroll
                    for (int j = 0; j < 4; ++j) { const float x = ci[j] - c32[j] - (i < 32 ? c31[j] : 0.f); qo[4 * j4 + j] = qf[4 * j4 + j] * __expf(x); ko[4 * j4 + j] = kf[4 * j4 + j] * __expf(-x); } }
                v4u wq, wk; wq.x = pk2(qo[0], qo[1]); wq.y = pk2(qo[2], qo[3]); wq.z = pk2(qo[4], qo[5]); wq.w = pk2(qo[6], qo[7]);
                wk.x = pk2(ko[0], ko[1]); wk.y = pk2(ko[2], ko[3]); wk.z = pk2(ko[4], ko[5]); wk.w = pk2(ko[6], ko[7]);
                *(v4u*)((dir ? QB : Q) + go) = wq; *(v4u*)((dir ? KB2 : Kb) + go) = wk; } }
    }
    __syncthreads();
}

__device__ __forceinline__ void gla_scan(const Frame& F) {
    const bf16* V = (const bf16*)(F.ws + WS_V); const float* DEC = (const float*)(F.ws + WS_DEC);
    LAS unsigned char* QI = F.lds; LAS unsigned char* KI = F.lds + 16384; LAS unsigned char* VV = F.lds + 32768; LAS float* DL = (LAS float*)(F.lds + 40960); LAS float* OP = (LAS float*)(F.lds + 49152);
    const int lane = F.lane, m = lane & 31, hh = lane >> 5, blk = (lane >> 4) & 1, q4 = (lane & 15) >> 2, p4 = lane & 3;
    const int t = F.wave >> 1, u = F.wave & 1;
    for (int it = F.vcu; it < 256; it += F.G) {
        const int dvs = it & 3, dir = (it >> 2) & 1, h = (it >> 3) & 3, b = it >> 5;
        const bf16* qiG = (const bf16*)(F.ws + (dir ? WS_QIB : WS_Q)); const bf16* kiG = (const bf16*)(F.ws + (dir ? WS_KIB : WS_K));
        bf16* O = (bf16*)(F.ws + (dir ? WS_OB : WS_OF));
        const float* decg = DEC + (size_t)(((b * 4 + h) * 2 + dir) * 32) * 384;
        f32x16 st;
#pragma unroll
        for (int r = 0; r < 16; ++r) st[r] = 0.f;
        v4u qreg[2], kreg[2], vreg; f32x4 dreg = {0.f, 0.f, 0.f, 0.f};
        const int qrow0 = F.tid >> 4, qch = F.tid & 15, vrow = F.tid >> 3, vch = F.tid & 7;
#define GLA_TOK(n, i) (b * 2048 + (dir ? 2047 - ((n) * 64 + (i)) : (n) * 64 + (i)))
#define GLA_LOAD(n) do { _Pragma("unroll") for (int k_ = 0; k_ < 2; ++k_) { const size_t go_ = (size_t)GLA_TOK(n, qrow0 + 32 * k_) * 512 + h * 128 + 8 * qch; qreg[k_] = *(const v4u*)(qiG + go_); kreg[k_] = *(const v4u*)(kiG + go_); } \
        vreg = *(const v4u*)(V + (size_t)GLA_TOK(n, vrow) * 1024 + h * 256 + dvs * 64 + 8 * vch); if (F.tid < 96) dreg = *(const f32x4*)(decg + (size_t)(n) * 384 + 4 * F.tid); } while (0)
        GLA_LOAD(0);
        for (int n = 0; n < 32; ++n) {
#pragma unroll
            for (int k = 0; k < 2; ++k) { *(LAS v4u*)(QI + off_b(qrow0 + 32 * k, qch)) = qreg[k]; *(LAS v4u*)(KI + off_b(qrow0 + 32 * k, qch)) = kreg[k]; }
            *(LAS v4u*)(VV + off_v(vrow, vch)) = vreg;
            if (F.tid < 96) *(LAS f32x4*)(DL + 4 * F.tid) = dreg;
            if (n + 1 < 32) GLA_LOAD(n + 1);
            __syncthreads();
            s16x8 kiA[2][2], qiB[2][2];
#pragma unroll
            for (int a = 0; a < 2; ++a)
#pragma unroll
                for (int s2 = 0; s2 < 2; ++s2) { kiA[a][s2] = *(const LAS s16x8*)(KI + off_b(32 * a + m, 4 * t + 2 * s2 + hh)); qiB[a][s2] = *(const LAS s16x8*)(QI + off_b(32 * a + m, 4 * t + 2 * s2 + hh)); }
            f32x16 P00, P01, P11;
#pragma unroll
            for (int r = 0; r < 16; ++r) { P00[r] = 0.f; P01[r] = 0.f; P11[r] = 0.f; }
#pragma unroll
            for (int s2 = 0; s2 < 2; ++s2) { P00 = MFMA32(kiA[0][s2], qiB[0][s2], P00); P01 = MFMA32(kiA[0][s2], qiB[1][s2], P01); P11 = MFMA32(kiA[1][s2], qiB[1][s2], P11); }
#pragma unroll
            for (int r = 0; r < 16; ++r) { const int jl = (r & 3) + 8 * (r >> 2) + 4 * hh; const bool keep = dir ? (jl < m) : (jl <= m); P00[r] = keep ? P00[r] : 0.f; P11[r] = keep ? P11[r] : 0.f; }
            f32x16 o0, o1;
#pragma unroll
            for (int r = 0; r < 16; ++r) { o0[r] = 0.f; o1[r] = 0.f; }
#pragma unroll
            for (int jt = 0; jt < 2; ++jt)
#pragma unroll
                for (int s2 = 0; s2 < 2; ++s2) {
                    const int rb = 32 * jt + 16 * s2 + 4 * hh + q4;
                    const s16x8 vb = cat8(tr_rd(VV + off_v(rb, 4 * u + 2 * blk + (p4 >> 1)) + 8 * (p4 & 1)), tr_rd(VV + off_v(rb + 8, 4 * u + 2 * blk + (p4 >> 1)) + 8 * (p4 & 1)));
                    if (jt == 0) { o0 = MFMA32(PACK_STEP(P00, s2), vb, o0); o1 = MFMA32(PACK_STEP(P01, s2), vb, o1); }
                    else o1 = MFMA32(PACK_STEP(P11, s2), vb, o1);
                }
            f32x16 ss;
#pragma unroll
            for (int g = 0; g < 4; ++g) { const f32x4 e = *(const LAS f32x4*)(DL + 32 * t + 8 * g + 4 * hh);
#pragma unroll
                for (int j = 0; j < 4; ++j) ss[4 * g + j] = st[4 * g + j] * e[j]; }
#pragma unroll
            for (int s2 = 0; s2 < 2; ++s2) {
                const s16x8 sb = PACK_STEP(ss, s2);
#pragma unroll
                for (int a = 0; a < 2; ++a) {
                    const s16x4 lo = *(const LAS s16x4*)(QI + off_b(32 * a + m, 4 * t + 2 * s2) + 8 * hh), hi = *(const LAS s16x4*)(QI + off_b(32 * a + m, 4 * t + 2 * s2 + 1) + 8 * hh);
                    if (a == 0) o0 = MFMA32(cat8(lo, hi), sb, o0); else o1 = MFMA32(cat8(lo, hi), sb, o1);
                }
            }
            f32x16 kv;
#pragma unroll
            for (int r = 0; r < 16; ++r) kv[r] = 0.f;
#pragma unroll
            for (int s4 = 0; s4 < 4; ++s4) {
                const int rb = 16 * s4 + 8 * hh + q4;
                const s16x8 ka = cat8(tr_rd(KI + off_b(rb, 4 * t + 2 * blk + (p4 >> 1)) + 8 * (p4 & 1)), tr_rd(KI + off_b(rb + 4, 4 * t + 2 * blk + (p4 >> 1)) + 8 * (p4 & 1)));
                const s16x8 vb = cat8(tr_rd(VV + off_v(rb, 4 * u + 2 * blk + (p4 >> 1)) + 8 * (p4 & 1)), tr_rd(VV + off_v(rb + 4, 4 * u + 2 * blk + (p4 >> 1)) + 8 * (p4 & 1)));
                kv = MFMA32(ka, vb, kv);
            }
#pragma unroll
            for (int g = 0; g < 4; ++g) { const f32x4 el = *(const LAS f32x4*)(DL + 128 + 32 * t + 8 * g + 4 * hh), er = *(const LAS f32x4*)(DL + 256 + 32 * t + 8 * g + 4 * hh);
#pragma unroll
                for (int j = 0; j < 4; ++j) st[4 * g + j] = st[4 * g + j] * el[j] + kv[4 * g + j] * er[j]; }
            { LAS float* op = OP + F.wave * 2048;
#pragma unroll
              for (int r = 0; r < 16; ++r) { const int il = (r & 3) + 8 * (r >> 2) + 4 * hh; op[il * 32 + m] = o0[r]; op[1024 + il * 32 + m] = o1[r]; } }
            __syncthreads();
            { const int i = F.tid >> 3, c8 = F.tid & 7, uu = c8 >> 2; f32x4 a0 = {0.f, 0.f, 0.f, 0.f}, a1 = {0.f, 0.f, 0.f, 0.f};
#pragma unroll
              for (int tt = 0; tt < 4; ++tt) { const LAS float* op = OP + (2 * tt + uu) * 2048 + (i >> 5) * 1024 + (i & 31) * 32 + 8 * (c8 & 3); a0 += *(const LAS f32x4*)op; a1 += *(const LAS f32x4*)(op + 4); }
              v4u w; w.x = pk2(a0[0], a0[1]); w.y = pk2(a0[2], a0[3]); w.z = pk2(a1[0], a1[1]); w.w = pk2(a1[2], a1[3]);
              *(v4u*)(O + (size_t)GLA_TOK(n, i) * 1024 + h * 256 + dvs * 64 + 8 * c8) = w; }
        }
#undef GLA_TOK
#undef GLA_LOAD
        __syncthreads();
    }
}

__device__ __forceinline__ void gla_finalize(const Frame& F, int l) {
    const bf16* Of = (const bf16*)(F.ws + WS_OF); const bf16* Ob = (const bf16*)(F.ws + WS_OB); bf16* R = (bf16*)(F.ws + WS_R);
    const float* gg = F_gla_g + l * 1024;
    const int gw = F.vcu * NWAVES + F.wave, NGW = F.G * NWAVES;
    for (int tok = gw; tok < MTOK; tok += NGW) {
        const size_t off = (size_t)tok * 1024 + 16 * F.lane;
        float o[16]; float ss = 0.f;
#pragma unroll
        for (int h = 0; h < 2; ++h) { const v4u a = *(const v4u*)(Of + off + 8 * h), c = *(const v4u*)(Ob + off + 8 * h);
            o[8 * h + 0] = bflo(a.x) + bflo(c.x); o[8 * h + 1] = bfhi(a.x) + bfhi(c.x); o[8 * h + 2] = bflo(a.y) + bflo(c.y); o[8 * h + 3] = bfhi(a.y) + bfhi(c.y);
            o[8 * h + 4] = bflo(a.z) + bflo(c.z); o[8 * h + 5] = bfhi(a.z) + bfhi(c.z); o[8 * h + 6] = bflo(a.w) + bflo(c.w); o[8 * h + 7] = bfhi(a.w) + bfhi(c.w); }
#pragma unroll
        for (int j = 0; j < 16; ++j) ss += o[j] * o[j];
        ss += __shfl_xor(ss, 1); ss += __shfl_xor(ss, 2); ss += __shfl_xor(ss, 4); ss += __shfl_xor(ss, 8);
        const float rs = rsqrtf(ss * (1.f / 256.f) + EPS);
#pragma unroll
        for (int h = 0; h < 2; ++h) { const v4u rr = *(const v4u*)(R + off + 8 * h); const f32x4 g0 = *(const f32x4*)(gg + 16 * F.lane + 8 * h), g1 = *(const f32x4*)(gg + 16 * F.lane + 8 * h + 4);
            v4u w;
            w.x = pk2(o[8 * h + 0] * rs * g0[0] * bflo(rr.x), o[8 * h + 1] * rs * g0[1] * bfhi(rr.x)); w.y = pk2(o[8 * h + 2] * rs * g0[2] * bflo(rr.y), o[8 * h + 3] * rs * g0[3] * bfhi(rr.y));
            w.z = pk2(o[8 * h + 4] * rs * g1[0] * bflo(rr.z), o[8 * h + 5] * rs * g1[1] * bfhi(rr.z)); w.w = pk2(o[8 * h + 6] * rs * g1[2] * bflo(rr.w), o[8 * h + 7] * rs * g1[3] * bfhi(rr.w));
            *(v4u*)(R + off + 8 * h) = w; }
    }
}

__device__ __forceinline__ void final_norm(const Frame& F) {
    const float* ssq = (const float*)(F.ws + WS_SSQ);
    const int gw = F.vcu * NWAVES + F.wave, NGW = F.G * NWAVES;
    for (int row = gw; row < MTOK; row += NGW) { const f32x4 p = *(const f32x4*)(ssq + (size_t)row * 4); const float rs = rsqrtf(((p[0] + p[1]) + (p[2] + p[3])) * (1.f / 1024.f) + EPS);
#pragma unroll
        for (int j = 0; j < 4; ++j) { const int k = 4 * F.lane + 256 * j; float* p4 = F.ka->out + (size_t)row * 1024 + k; const f32x4 xv = *(const f32x4*)p4; const f32x4 g = *(const f32x4*)(F_final_g + k);
            *(f32x4*)p4 = xv * rs * g; } }
}

constexpr int N_PRO = 3, PH_PER_LAYER = 5, N_PHASES = N_PRO + DEPTH * PH_PER_LAYER + 1;

__global__ void __launch_bounds__(NTHR, 2) mk_fwd(Args args) {
    extern __shared__ __attribute__((aligned(16))) unsigned char lds[];
    LAS unsigned char* const L = (LAS unsigned char*)lds;
    volatile LAS unsigned* MISC = (volatile LAS unsigned*)(L + MISC_OFF);
    if (threadIdx.x < 32) MISC[threadIdx.x] = 0u;
    __syncthreads();
    const int lo = args.ph_lo, hi = args.ph_hi;
    XcdBarrier bar; bar.bar = (unsigned*)(args.ws + WS_CTL) + CW_BAR; bar.x = 0; bar.st = nullptr;
    if (hi - lo > 1) bar = xcd_barrier_post((unsigned*)(args.ws + WS_CTL) + CW_BAR, MISC + 8);
#define IN(k) (lo <= (k) && (k) < hi)
#define SEAM(k) do { if (IN(k) && IN((k) + 1)) xcd_barrier(bar); } while (0)

    if (IN(0)) { const Frame F = make_frame(L); phase_p0(F); } SEAM(0);
    if (IN(1)) {
        { const Frame F = make_frame(L);
          pg8::Gemm g{(const bf16*)(F.ws + WS_WFT), nullptr, (const bf16*)(F.ws + WS_TR), 256, 256, 256, 4};
          pg8::WcOrder S{F.G, (int)blockIdx.x}; EpiStore E{(bf16*)(F.ws + WS_WCT), 256};
          pg8::gemm_phase<EpiStore, pg8::WcOrder, true>(F.lds, F.tid, g, S, E); }
        { const Frame F = make_frame(L); phase_p1(F); }
    } SEAM(1);
    if (IN(2)) {
        { const Frame F = make_frame(L);
          pg8::Gemm g{(const bf16*)(F.ws + WS_WCT), nullptr, (const bf16*)(F.ws + WS_WU), 256, 256, 1024, 4};
          pg8::FoldOrder S{F.G, (int)blockIdx.x}; EpiStore E{(bf16*)(F.ws + WS_WTIN), 1024};
          pg8::gemm_phase<EpiStore, pg8::FoldOrder, true>(F.lds, F.tid, g, S, E); }
        { const Frame F = make_frame(L); phase_p2(F); }
    } SEAM(2);

    for (int l = 0; l < DEPTH; ++l) {
        const int pb = N_PRO + l * PH_PER_LAYER;
        if (IN(pb + 0)) {
            { const Frame F = make_frame(L);
              const bf16* wtin = (const bf16*)(F.ws + WS_WTIN) + (size_t)l * NPJ * 1024; const float* sw = (const float*)(F.ws + WS_SW) + (size_t)l * 8 * NSW;
              pg8::Gemm g{wtin, nullptr, (const bf16*)(F.ws + WS_XG),  1024, 1024, 1024, 16};
              pg8::StaticOrder S; S.init(2048, MTOK, F.G, (int)blockIdx.x);
              EpiAB E{(const float*)(F.ws + WS_SSQ), sw, (bf16*)(F.ws + WS_AB)};
              pg8::gemm_phase<EpiAB, pg8::StaticOrder, true>(F.lds, F.tid, g, S, E); }
            { const Frame F = make_frame(L);
              const bf16* wtin = (const bf16*)(F.ws + WS_WTIN) + (size_t)l * NPJ * 1024; const float* sw = (const float*)(F.ws + WS_SW) + (size_t)l * 8 * NSW;
              pg8::Gemm g{(const bf16*)(F.ws + WS_XG), nullptr, wtin + (size_t)2048 * 1024,  1024, 1024, 1024, 16};
              pg8::StaticOrder S; S.init(MTOK, 4096, F.G, (int)blockIdx.x);
              EpiProj E{(const float*)(F.ws + WS_SSQ), sw, F.ws};
              pg8::gemm_phase<EpiProj, pg8::StaticOrder, true>(F.lds, F.tid, g, S, E); }
            { const Frame F = make_frame(L); gate_rows(F, l); }
        }
        SEAM(pb + 0);
        if (IN(pb + 1)) {
            const Frame F = make_frame(L);
            fourier_ct(F);
            { const Frame F2 = make_frame(L); gla_prep(F2, l); }
        }
        SEAM(pb + 1);
        if (IN(pb + 2)) { const Frame F = make_frame(L); gla_scan(F); }
        SEAM(pb + 2);
        if (IN(pb + 3)) { const Frame F = make_frame(L); gla_finalize(F, l); }
        SEAM(pb + 3);
        if (IN(pb + 4)) {
            const Frame F = make_frame(L);
            const float* mod = (const float*)(F.ws + WS_MOD);
            pg8::Gemm g{(const bf16*)(F.ws + WS_ZF), (const bf16*)(F.ws + WS_R), (const bf16*)(F.ws + WS_WTOUT) + (size_t)l * 1024 * 2048, 2048, 1024, 2048, 16};
            pg8::StaticOrder S; S.init(MTOK, 1024, F.G, (int)blockIdx.x);
            EpiOut E{l == 0 ? F_x : (const float*)F.ka->out, F.ka->out, (bf16*)(F.ws + WS_XG), (float*)(F.ws + WS_SSQ), mod + (size_t)l * 8 * 3072 + 2048,
                     l + 1 < DEPTH ? (const float*)(F.ws + WS_GMOD) + (size_t)(l + 1) * 8 * 1024 : nullptr};
            if (F.G == 256) pg8::gemm_phase<EpiOut, pg8::StaticOrder, false>(F.lds, F.tid, g, S, E);
        }
        SEAM(pb + 4);
    }
    if (IN(N_PHASES - 1)) { const Frame F = make_frame(L); final_norm(F); }
#undef IN
#undef SEAM
}

extern "C" void kernel_launch(void* const* d_in, const int* in_sizes, int n_in, void* d_out, int out_size, void* d_ws, size_t ws_size, hipStream_t stream) {
    static int grid = 0;
    if (grid == 0) {
        if (n_in != 14 || out_size != MTOK * D || ws_size < WS_END) { fprintf(stderr, "kernel_launch: unexpected problem (n_in %d, out %d, ws %zu < %zu)\n", n_in, out_size, ws_size, (size_t)WS_END); grid = -1; return; }
        int dev = 0, cus = 0;
        if (hipGetDevice(&dev) != hipSuccess || hipDeviceGetAttribute(&cus, hipDeviceAttributeMultiprocessorCount, dev) != hipSuccess) { grid = -1; return; }
        if (hipFuncSetAttribute((const void*)mk_fwd, hipFuncAttributeMaxDynamicSharedMemorySize, LDS_BYTES) != hipSuccess) { fprintf(stderr, "kernel_launch: hipFuncSetAttribute failed\n"); grid = -1; return; }
        (void)hipGetLastError();
        grid = cus;
        if (grid != 256) fprintf(stderr, "kernel_launch: %d CUs; built for 256\n", grid);
    }
    if (grid < 0) return;
    (void)hipMemsetAsync((char*)d_ws + WS_CTL, 0, CTL_ZERO_BYTES, stream);
    Args a{};
    for (int i = 0; i < 14; ++i) a.in[i] = (const float*)d_in[i];
    a.out = (float*)d_out; a.ws = (unsigned char*)d_ws;
#if MK_PER_PHASE
    for (int p = 0; p < N_PHASES; ++p) { a.ph_lo = p; a.ph_hi = p + 1; hipLaunchKernelGGL(mk_fwd, dim3(grid), dim3(NTHR), LDS_BYTES, stream, a); }
#else
    a.ph_lo = 0; a.ph_hi = N_PHASES; hipLaunchKernelGGL(mk_fwd, dim3(grid), dim3(NTHR), LDS_BYTES, stream, a);
#endif
}
```

```cpp
#include <hip/hip_runtime.h>
#include <cstdio>
#include <cstdint>

#ifndef MK_PER_PHASE
#define MK_PER_PHASE 0
#endif

namespace pg8 {
#define PG8_LAS __attribute__((address_space(3)))
typedef unsigned short bf16_t;
typedef short bf16x8 __attribute__((ext_vector_type(8)));
typedef float f32x4 __attribute__((ext_vector_type(4)));
typedef unsigned u32x4 __attribute__((ext_vector_type(4)));
typedef unsigned u32x2 __attribute__((ext_vector_type(2)));
constexpr int BM = 256, BK = 64, HALF = 128, HTB = HALF * BK * 2  , STAGE_BYTES = 8 * HTB, NXCD = 8, WGM = 8;

__host__ __device__ __forceinline__ int lds_byte(int r, int c) { const int st = (r >> 4) * 2 + (c >> 5), rr = r & 15, cc = c & 31, ob = rr * 64 + cc * 2; return st * 1024 + (ob ^ (((ob >> 9) & 1) << 5)); }
__host__ __device__ __forceinline__ void stage_rc(int b, int& R, int& C) { const int st = b / 1024, sb = b % 1024, swz = sb ^ (((sb >> 9) & 1) << 5); R = (st >> 1) * 16 + swz / 64; C = (st & 1) * 32 + (swz % 64) / 2; }
__host__ __device__ __forceinline__ int perm32(int rho) { const int n = rho >> 4, i = rho & 15; return 8 * (i >> 2) + 4 * n + (i & 3); }

struct Unit { int pm, pn, bz; unsigned aoff, boff, coff; };
struct Gemm { const bf16_t* A; const bf16_t* A2; const bf16_t* Bt; int K, lda, ldb, ksplit; };

struct StaticOrder {
    int nM, nN, nwg, G, c;
    __host__ __device__ void init(int M, int N, int G_, int c_) { nM = M / BM; nN = N / BM; nwg = nM * nN; G = G_; c = c_; }
    __host__ __device__ bool next(int i, Unit& u) const {
        const long L = (long)i * G + c; if (L >= nwg) return false;
        int wgid = (int)L; { const int q = nwg / NXCD, r = nwg % NXCD, xcd = wgid % NXCD, off = wgid / NXCD; wgid = (xcd < r ? xcd * (q + 1) : r * (q + 1) + (xcd - r) * q) + off; }
        const int nig = WGM * nN, gid = wgid / nig, fm = gid * WGM, gsz = (nM - fm) < WGM ? (nM - fm) : WGM;
        u.pm = fm + ((wgid % nig) % gsz); u.pn = (wgid % nig) / gsz; u.bz = 0; u.aoff = 0u; u.boff = 0u; u.coff = 0u; return true;
    }
};
struct BatchOrder {
    int nM, nN, G, c;
    __host__ __device__ void init(int M, int N, int G_, int c_) { nM = M / BM; nN = N / BM; G = G_; c = c_; }
    __host__ __device__ bool next(int i, Unit& u) const {
        const int per = nM * nN; const long L = (long)i * G + c; if (L >= 8L * per) return false;
        const int bz = (int)(L % 8), t = (int)(L / 8); u.bz = bz; u.pm = t / nN; u.pn = t % nN; u.aoff = 0u; u.boff = (unsigned)bz * (1024u * 4096u * 2u); u.coff = 0u; return true;
    }
};

struct WcOrder {
    int G, c;
    __host__ __device__ bool next(int i, Unit& u) const { const int L = i * G + c; if (L >= 32) return false;
        u.pm = 0; u.pn = 0; u.bz = L; u.aoff = (unsigned)(L >> 1) * 131072u; u.boff = (unsigned)(L & 1) * 131072u; u.coff = (unsigned)L * 65536u; return true; }
};
struct FoldOrder {
    int G, c;
    __host__ __device__ bool next(int i, Unit& u) const { const int L = i * G + c; if (L >= 128) return false;
        const int z = L >> 2, part = z & 1, g = (z >> 1) & 3, l = z >> 3;
        u.pm = 0; u.pn = L & 3; u.bz = z; u.aoff = (unsigned)z * 131072u; u.boff = (unsigned)(l * 1048576 + g * 256) * 2u; u.coff = (unsigned)((l * 6144 + part * 1024 + g * 256) * 1024); return true; }
};

typedef float f32x2_t __attribute__((ext_vector_type(2)));
typedef __bf16 b16x2_t __attribute__((ext_vector_type(2)));
__device__ __forceinline__ unsigned cvt_pk_bf16(float lo, float hi) { const f32x2_t v = {lo, hi}; return __builtin_bit_cast(unsigned, __builtin_convertvector(v, b16x2_t)); }

template <class Epi, class Sched, bool ALIGN_EPI>
__device__ __forceinline__ void gemm_phase(PG8_LAS unsigned char* lds, const int tid, const Gemm g, const Sched& S, const Epi& E) {
    const int wid = __builtin_amdgcn_readfirstlane(tid >> 6), lane = tid & 63, wr = wid >> 2, wc = wid & 3, fr = lane & 15, fq = lane >> 4;
    const int K = g.K, nt = K / BK, ks = g.ksplit;
    unsigned voffA[2], voffB[2];
#pragma unroll
    for (int i = 0; i < 2; ++i) { int R, C; stage_rc(tid * 16 + i * 8192, R, C); const int Rb = Epi::PERM ? ((R & ~31) + perm32(R & 31)) : R;
        voffA[i] = (unsigned)(R * g.lda + C) * 2u; voffB[i] = (unsigned)(Rb * g.ldb + C) * 2u; }
    const size_t kstep = (size_t)(BK * 2);
    const size_t hstepA = (size_t)HALF * g.lda * 2, tstepA = 2 * hstepA, hstepB = (size_t)HALF * g.ldb * 2, tstepB = 2 * hstepB;
    const unsigned ldsw = (unsigned)wid * 1024u;
    const int aoff = lds_byte(wr * 64 + fr, fq * 8), boff = lds_byte(wc * 32 + fr, fq * 8);
#define PG8_SA(b, h) (((b) * 2 + (h)) * HTB)
#define PG8_SB(b, h) ((4 + (b) * 2 + (h)) * HTB)
#define PG8_STAGE(bufoff, gbase, voff) do { _Pragma("unroll") for (int _i = 0; _i < 2; ++_i) \
        __builtin_amdgcn_global_load_lds((const unsigned*)((const char*)(gbase) + (voff)[_i]), (PG8_LAS unsigned*)(lds + (bufoff) + ldsw + _i * 8192), 16, 0, 0); } while (0)
#define PG8_LDA(dst, b, h) do { _Pragma("unroll") for (int m = 0; m < 4; ++m) _Pragma("unroll") for (int k = 0; k < 2; ++k) dst[m][k] = *(const PG8_LAS bf16x8*)(lds + PG8_SA(b, h) + aoff + m * 2048 + k * 1024); } while (0)
#define PG8_LDB(dst, b, h) do { _Pragma("unroll") for (int n = 0; n < 2; ++n) _Pragma("unroll") for (int k = 0; k < 2; ++k) dst[n][k] = *(const PG8_LAS bf16x8*)(lds + PG8_SB(b, h) + boff + n * 2048 + k * 1024); } while (0)
#define PG8_MMA(ai, bj, At, Bt) do { __builtin_amdgcn_s_setprio(1); _Pragma("unroll") for (int m = 0; m < 4; ++m) _Pragma("unroll") for (int n = 0; n < 2; ++n) _Pragma("unroll") for (int k = 0; k < 2; ++k) \
        acc[ai][bj][m][n] = __builtin_amdgcn_mfma_f32_16x16x32_bf16(Bt[n][k], At[m][k], acc[ai][bj][m][n], 0, 0, 0); __builtin_amdgcn_s_setprio(0); } while (0)
#define PG8_WAIT_V(n) asm volatile("s_waitcnt vmcnt(" #n ")" ::: "memory")
#define PG8_WAIT_L(n) asm volatile("s_waitcnt lgkmcnt(" #n ")" ::: "memory")
#define PG8_BAR __builtin_amdgcn_s_barrier()
#define PG8_SCHED __builtin_amdgcn_sched_barrier(0)
#define PG8_APT(b1, t) ((b1) + (long long)(t) * (long long)kstep + ((t) >= ks ? d2 : 0ll))
    Unit cur, nxt; int ui = 0;
    if (!S.next(0, cur)) return;
    f32x4 acc[2][2][4][2];
#pragma unroll
    for (int a = 0; a < 2; ++a)
#pragma unroll
        for (int b = 0; b < 2; ++b)
#pragma unroll
            for (int m = 0; m < 4; ++m)
#pragma unroll
                for (int n = 0; n < 2; ++n) acc[a][b][m][n] = (f32x4){0.f, 0.f, 0.f, 0.f};
    bf16x8 At[4][2], B0[2][2], B1[2][2];
    const char* cA = (const char*)g.A + (size_t)cur.aoff + (size_t)cur.pm * tstepA;
    const long long d2 = g.A2 ? ((const char*)g.A2 - (const char*)g.A) - (long long)ks * (long long)kstep : 0ll;
    const char* cB = (const char*)g.Bt + (size_t)cur.boff + (size_t)cur.pn * tstepB;
    PG8_STAGE(PG8_SB(0, 0), cB, voffB); PG8_STAGE(PG8_SB(0, 1), cB + hstepB, voffB); PG8_STAGE(PG8_SA(0, 0), cA, voffA); PG8_STAGE(PG8_SA(0, 1), cA + hstepA, voffA);
    if (wr == 1) PG8_BAR;
    PG8_WAIT_V(2); PG8_BAR;
    PG8_STAGE(PG8_SB(1, 0), cB + kstep, voffB); PG8_STAGE(PG8_SA(1, 0), cA + kstep, voffA); PG8_STAGE(PG8_SB(1, 1), cB + hstepB + kstep, voffB);
    PG8_WAIT_V(6); PG8_BAR;
    for (;;) {
        const bool has_next = S.next(ui + 1, nxt);
        const char* nA = has_next ? (const char*)g.A + (size_t)nxt.aoff + (size_t)nxt.pm * tstepA : cA;
        const char* nB = has_next ? (const char*)g.Bt + (size_t)nxt.boff + (size_t)nxt.pn * tstepB : cB;
#pragma nounroll
        for (int t = 0; t < nt; t += 2) {
            const bool last = (t == nt - 2);
            const char* a1 = PG8_APT(cA, t + 1);
            const char* a2 = last ? nA : PG8_APT(cA, t + 2); const char* b2 = last ? nB : cB + (size_t)(t + 2) * kstep;
            const char* a3 = last ? nA + kstep : PG8_APT(cA, t + 3); const char* b3 = b2 + kstep;
            PG8_LDB(B0, 0, 0); PG8_LDB(B1, 0, 1); PG8_SCHED; PG8_LDA(At, 0, 0); PG8_STAGE(PG8_SA(1, 1), a1 + hstepA, voffA);
            PG8_WAIT_V(8); PG8_WAIT_L(0); PG8_BAR; PG8_MMA(0, 0, At, B0); PG8_MMA(0, 1, At, B1); PG8_BAR; PG8_SCHED;
            PG8_LDA(At, 0, 1); PG8_STAGE(PG8_SB(0, 0), b2, voffB); PG8_STAGE(PG8_SB(0, 1), b2 + hstepB, voffB); PG8_STAGE(PG8_SA(0, 0), a2, voffA);
            PG8_WAIT_V(8); PG8_WAIT_L(0); PG8_BAR; PG8_MMA(1, 0, At, B0); PG8_MMA(1, 1, At, B1); PG8_BAR; PG8_SCHED;
            PG8_LDB(B0, 1, 0); PG8_LDB(B1, 1, 1); PG8_SCHED; PG8_LDA(At, 1, 0); PG8_STAGE(PG8_SA(0, 1), a2 + hstepA, voffA);
            PG8_WAIT_V(8); PG8_WAIT_L(0); PG8_BAR; PG8_MMA(0, 0, At, B0); PG8_MMA(0, 1, At, B1); PG8_BAR; PG8_SCHED;
            PG8_LDA(At, 1, 1); PG8_STAGE(PG8_SB(1, 0), b3, voffB); PG8_STAGE(PG8_SB(1, 1), b3 + hstepB, voffB); PG8_STAGE(PG8_SA(1, 0), a3, voffA);
            PG8_WAIT_V(8); PG8_WAIT_L(0); PG8_BAR; PG8_MMA(1, 0, At, B0); PG8_MMA(1, 1, At, B1); PG8_BAR; PG8_SCHED;
        }
        if constexpr (ALIGN_EPI) { if (wr == 0) PG8_BAR; }
        if constexpr (!Epi::AFTER_DRAIN) { E(acc, cur, wr, wc, fr, fq); }
        if (!has_next) break;
#pragma unroll
        for (int a = 0; a < 2; ++a)
#pragma unroll
            for (int b = 0; b < 2; ++b)
#pragma unroll
                for (int m = 0; m < 4; ++m)
#pragma unroll
                    for (int n = 0; n < 2; ++n) acc[a][b][m][n] = (f32x4){0.f, 0.f, 0.f, 0.f};
        cur = nxt; cA = nA; cB = nB; ++ui;
        if constexpr (ALIGN_EPI) { if (wr == 1) PG8_BAR; }
    }
    PG8_WAIT_V(0);
    if constexpr (!ALIGN_EPI) { if (wr == 0) PG8_BAR; }
    PG8_BAR;
    if constexpr (Epi::AFTER_DRAIN) { E.fused(acc, cur, wr, wc, fr, fq, lds, wid, lane); }
#undef PG8_SA
#undef PG8_SB
#undef PG8_STAGE
#undef PG8_LDA
#undef PG8_LDB
#undef PG8_MMA
#undef PG8_WAIT_V
#undef PG8_WAIT_L
#undef PG8_BAR
#undef PG8_SCHED
#undef PG8_APT
}
}

constexpr int NWAVES = 8, NTHR = NWAVES * 64;
constexpr int D = 1024, BATCH = 8, SEQ = 2048, DEPTH = 4, MTOK = BATCH * SEQ;
constexpr int DIN = 5152;
constexpr int NPJ = 6144;
constexpr int NSW = 6176;
constexpr float EPS = 1e-6f;

constexpr size_t MiB = 1u << 20;
constexpr size_t WS_CTL = 0, CTL_ZERO_BYTES = 65536;
constexpr size_t WS_MOD = 1 * MiB;
constexpr size_t WS_GMOD = WS_MOD + 512 * 1024;
constexpr size_t WS_SWRAW = 2 * MiB;
constexpr size_t WS_SW = 3 * MiB;
constexpr size_t WS_SSQ = 4 * MiB;
constexpr size_t WS_GLOW = WS_SSQ + 512 * 1024;
constexpr size_t WS_WTG = WS_GLOW + 2 * MiB;
constexpr size_t WS_WTIN = 7 * MiB;
constexpr size_t WS_WTOUT = 55 * MiB;
constexpr size_t WS_TM1 = 71 * MiB;
constexpr size_t WS_TM2 = WS_TM1 + 8192;
constexpr size_t WS_TTW = WS_TM2 + 16384;
constexpr size_t WS_XG = 87 * MiB;
constexpr size_t WS_AB = 119 * MiB;
constexpr size_t WS_ZF = 183 * MiB;
constexpr size_t WS_Q = 215 * MiB;
constexpr size_t WS_K = 231 * MiB;
constexpr size_t WS_V = 247 * MiB;
constexpr size_t WS_R = 279 * MiB;
constexpr size_t WS_DEC = 311 * MiB;
constexpr size_t WS_END = 315 * MiB;
constexpr size_t WS_QIB = WS_XG, WS_KIB = WS_XG + 16 * MiB;
constexpr size_t WS_OF = WS_AB, WS_OB = WS_AB + 32 * MiB;
constexpr size_t WS_WFT = WS_AB;
constexpr size_t WS_TR = WS_AB + 2 * MiB;
constexpr size_t WS_WCT = WS_AB + 3 * MiB;
constexpr size_t WS_WU = WS_AB + 8 * MiB;
constexpr int CW_BAR = 4096;

constexpr int LDS_BYTES = 156672;
constexpr int RING_BYTES = 131072;
constexpr int MISC_OFF = 155648 + 320;

#define GAS __attribute__((address_space(1)))
#define LAS __attribute__((address_space(3)))
typedef unsigned short bf16;
typedef unsigned v4u __attribute__((ext_vector_type(4)));
typedef unsigned v2u __attribute__((ext_vector_type(2)));
typedef float f32x4 __attribute__((ext_vector_type(4)));
typedef GAS unsigned gu32;
#define LDS_WAIT() asm volatile("s_waitcnt lgkmcnt(0)" ::: "memory")
__device__ __forceinline__ unsigned f2bf(float f) { unsigned u = __builtin_bit_cast(unsigned, f); return (u + 0x7fffu + ((u >> 16) & 1u)) >> 16; }
__device__ __forceinline__ unsigned pk2(float lo, float hi) { return f2bf(lo) | (f2bf(hi) << 16); }
__device__ __forceinline__ float bflo(unsigned u) { return __builtin_bit_cast(float, u << 16); }
__device__ __forceinline__ float bfhi(unsigned u) { return __builtin_bit_cast(float, u & 0xffff0000u); }
__device__ __forceinline__ float bf2f(bf16 h) { return __builtin_bit_cast(float, (unsigned)h << 16); }
__device__ __forceinline__ float silu_f(float x) { return x / (1.f + __expf(-x)); }
__device__ __forceinline__ float logsig_f(float z) { return fminf(z, 0.f) - log1pf(__expf(-fabsf(z))); }

#define XB_TMO      128
#define XB_XCNT(j)  (256  + 64 * (j))
#define XB_XSUB(j)  (1280 + 64 * (j))
#define XB_XGEN(j)  (2304 + 64 * (j))
#define XB_TOP      3328
#define XB_TOPGEN   3392
#define XCD_BAR_WORDS 3456
#define XB_SPIN_CAP (1u << 18)
__device__ __forceinline__ unsigned xb_ld(unsigned* p)              { return __hip_atomic_load(p, __ATOMIC_RELAXED, __HIP_MEMORY_SCOPE_AGENT); }
__device__ __forceinline__ unsigned xb_add(unsigned* p, unsigned v) { return __hip_atomic_fetch_add(p, v, __ATOMIC_RELAXED, __HIP_MEMORY_SCOPE_AGENT); }
__device__ __forceinline__ unsigned xb_xcc_id() { return (unsigned)__builtin_amdgcn_s_getreg((3 << 11) | 20) & 0xFu; }
#define XB_SPIN(cond, bar) do { unsigned _sp = 0; while (cond) { __builtin_amdgcn_s_sleep(1); \
    if ((++_sp & 255u) == 0u) { if (xb_ld(&(bar)[XB_TMO])) break; if (_sp > XB_SPIN_CAP) { atomicAdd(&(bar)[XB_TMO], 1u); break; } } } } while (0)
struct XcdBarrier { unsigned* bar; unsigned x; volatile LAS unsigned* st; };
__device__ __forceinline__ XcdBarrier xcd_barrier_post(unsigned* bar, volatile LAS unsigned* st) {
    XcdBarrier b; b.bar = bar; b.x = xb_xcc_id(); b.st = st;
    if (threadIdx.x == 0) (void)xb_add(&bar[XB_XCNT(b.x)], 1u);
    return b;
}
__device__ __forceinline__ void xcd_barrier_complete(unsigned* bar, unsigned x, unsigned& nloc, unsigned& nx) {
    const unsigned G = gridDim.x * gridDim.y * gridDim.z;
    unsigned sum, cnt, mine, sp = 0u;
    for (;;) {
        sum = 0u; cnt = 0u; mine = 0u;
#pragma unroll
        for (unsigned j = 0; j < 16; ++j) { const unsigned c = xb_ld(&bar[XB_XCNT(j)]); sum += c; cnt += (c > 0u) ? 1u : 0u; mine = (j == x) ? c : mine; }
        if (sum == G) break;
        __builtin_amdgcn_s_sleep(1);
        if ((++sp & 255u) == 0u) { if (xb_ld(&bar[XB_TMO])) break; if (sp > XB_SPIN_CAP) { atomicAdd(&bar[XB_TMO], 1u); break; } }
    }
    nloc = mine > 0u ? mine : 1u; nx = cnt > 0u ? cnt : 1u;
}
__device__ __forceinline__ void xcd_barrier(const XcdBarrier& b) {
    asm volatile("s_waitcnt vmcnt(0)" ::: "memory");
    __syncthreads();
    if (threadIdx.x == 0) {
        unsigned* bar = b.bar;
        __builtin_amdgcn_s_waitcnt(0);
        unsigned nloc = b.st[0], nx = b.st[1];
        if (nloc == 0u) { xcd_barrier_complete(bar, b.x, nloc, nx); b.st[0] = nloc; b.st[1] = nx; }
        const unsigned old = xb_add(&bar[XB_XSUB(b.x)], 1u);
        const unsigned gen = old / nloc;
        if (old + 1u == (gen + 1u) * nloc) {
            __builtin_amdgcn_fence(__ATOMIC_RELEASE, "agent");
            asm volatile("s_waitcnt vmcnt(0)" ::: "memory");
            const unsigned og = xb_add(&bar[XB_TOP], 1u);
            const unsigned tg = og / nx;
            if (og + 1u == (tg + 1u) * nx) xb_add(&bar[XB_TOPGEN], 1u);
            else XB_SPIN(xb_ld(&bar[XB_TOPGEN]) == tg, bar);
            __builtin_amdgcn_fence(__ATOMIC_ACQUIRE, "agent");
            xb_add(&bar[XB_XGEN(b.x)], 1u);
            asm volatile("s_waitcnt vmcnt(0)" ::: "memory");
        } else {
            XB_SPIN(xb_ld(&bar[XB_XGEN(b.x)]) == gen, bar);
            __builtin_amdgcn_fence(__ATOMIC_ACQUIRE, "agent");
            asm volatile("s_waitcnt vmcnt(0)" ::: "memory");
        }
    }
    __syncthreads();
}

struct Args { const float* in[14]; float* out; unsigned char* ws; int ph_lo, ph_hi; };
typedef const __attribute__((address_space(4))) Args* KArgs;
struct Frame {
    LAS unsigned char* lds;
    int tid, lane, wave, vcu, G;
    KArgs ka; unsigned char* ws;
    __device__ __forceinline__ const float* in(int k) const { return ka->in[k]; }
};
#define F_x F.in(0)
#define F_c F.in(1)
#define F_norm_g F.in(2)
#define F_w_ada F.in(3)
#define F_b_ada F.in(4)
#define F_w_in F.in(5)
#define F_w_fmap F.in(6)
#define F_w_af F.in(7)
#define F_b_af F.in(8)
#define F_w_ab F.in(9)
#define F_b_ab F.in(10)
#define F_gla_g F.in(11)
#define F_w_out F.in(12)
#define F_final_g F.in(13)
__device__ __forceinline__ Frame make_frame(LAS unsigned char* lds) {
    Frame F; F.lds = lds;
    int t = threadIdx.x; asm volatile("" : "+v"(t));
    KArgs ka = (KArgs)__builtin_amdgcn_kernarg_segment_ptr(); asm volatile("" : "+s"(ka));
    F.ka = ka; F.ws = ka->ws;
    F.tid = t; F.lane = t & 63; F.wave = __builtin_amdgcn_readfirstlane(t >> 6);
    F.G = gridDim.x; { const int bx = blockIdx.x; F.vcu = (F.G % 8 == 0) ? (bx % 8) * (F.G / 8) + bx / 8 : bx; }
    return F;
}

struct EpiProj {
    static constexpr bool PERM = true, AFTER_DRAIN = false;
    const float* ssq; const float* sw;
    unsigned char* ws;
    __device__ __forceinline__ void operator()(const pg8::f32x4 (&acc)[2][2][4][2], const pg8::Unit& u, int wr, int wc, int fr, int fq) const {
        const int b = u.pm >> 3, pn = u.pn;
        bf16* dst; int ldc, dcol; int mode;
        if (pn < 4) { dst = (bf16*)(ws + WS_ZF); ldc = 1024; dcol = pn * 256; mode = 1; }
        else if (pn < 6) { dst = (bf16*)(ws + WS_Q); ldc = 512; dcol = (pn - 4) * 256; mode = 2; }
        else if (pn < 8) { dst = (bf16*)(ws + WS_K); ldc = 512; dcol = (pn - 6) * 256; mode = 0; }
        else if (pn < 12) { dst = (bf16*)(ws + WS_V); ldc = 1024; dcol = (pn - 8) * 256; mode = 0; }
        else { dst = (bf16*)(ws + WS_R); ldc = 1024; dcol = (pn - 12) * 256; mode = 1; }
        const int col0 = wc * 32 + 8 * fq;
        pg8::f32x4 bv[2][2];
#pragma unroll
        for (int bj = 0; bj < 2; ++bj)
#pragma unroll
            for (int n = 0; n < 2; ++n) bv[bj][n] = *(const pg8::f32x4*)(sw + (size_t)b * NSW + 2048 + pn * 256 + col0 + bj * 128 + 4 * n);
#pragma unroll
        for (int ai = 0; ai < 2; ++ai)
#pragma unroll
            for (int m = 0; m < 4; ++m) {
                const int row = u.pm * 256 + ai * 128 + wr * 64 + m * 16 + fr;
                const pg8::f32x4 p = *(const pg8::f32x4*)(ssq + (size_t)row * 4);
                const float rs = rsqrtf(((p[0] + p[1]) + (p[2] + p[3])) * (1.f / 1024.f) + EPS);
                bf16* rowp = dst + (size_t)row * ldc + dcol + col0;
#pragma unroll
                for (int bj = 0; bj < 2; ++bj) {
                    pg8::f32x4 v0 = acc[ai][bj][m][0] * rs + bv[bj][0], v1 = acc[ai][bj][m][1] * rs + bv[bj][1];
                    if (mode == 1) {
#pragma unroll
                        for (int j = 0; j < 4; ++j) { v0[j] = silu_f(v0[j]); v1[j] = silu_f(v1[j]); }
                    } else if (mode == 2) { v0 = v0 * 0.08838834764831845f; v1 = v1 * 0.08838834764831845f; }
                    pg8::u32x4 w; w.x = pg8::cvt_pk_bf16(v0[0], v0[1]); w.y = pg8::cvt_pk_bf16(v0[2], v0[3]); w.z = pg8::cvt_pk_bf16(v1[0], v1[1]); w.w = pg8::cvt_pk_bf16(v1[2], v1[3]);
                    *(pg8::u32x4*)(rowp + bj * 128) = w;
                }
            }
    }
};
struct EpiAB {
    static constexpr bool PERM = true, AFTER_DRAIN = false;
    const float* ssq; const float* sw; bf16* abT;
    __device__ __forceinline__ void operator()(const pg8::f32x4 (&acc)[2][2][4][2], const pg8::Unit& u, int wr, int wc, int fr, int fq) const {
        const int b = u.pn >> 3, pos0 = (u.pn & 7) * 256 + wc * 32 + 8 * fq, tok0 = u.pn * 256 + wc * 32 + 8 * fq;
        pg8::f32x4 rs[2][2];
#pragma unroll
        for (int bj = 0; bj < 2; ++bj)
#pragma unroll
            for (int n = 0; n < 2; ++n)
#pragma unroll
                for (int j = 0; j < 4; ++j) {
                    const pg8::f32x4 p = *(const pg8::f32x4*)(ssq + (size_t)(tok0 + bj * 128 + 4 * n + j) * 4);
                    rs[bj][n][j] = rsqrtf(((p[0] + p[1]) + (p[2] + p[3])) * (1.f / 1024.f) + EPS);
                }
#pragma unroll
        for (int ai = 0; ai < 2; ++ai)
#pragma unroll
            for (int m = 0; m < 4; ++m) {
                const int np = u.pm * 256 + ai * 128 + wr * 64 + m * 16 + fr;
                const float bias = sw[(size_t)b * NSW + np];
                bf16* rowp = abT + ((size_t)(b * 1024 + (np & 1023)) * 4096 + (size_t)(np >> 10) * 2048 + pos0);
#pragma unroll
                for (int bj = 0; bj < 2; ++bj) {
                    const pg8::f32x4 v0 = acc[ai][bj][m][0] * rs[bj][0] + bias, v1 = acc[ai][bj][m][1] * rs[bj][1] + bias;
                    pg8::u32x4 w; w.x = pg8::cvt_pk_bf16(v0[0], v0[1]); w.y = pg8::cvt_pk_bf16(v0[2], v0[3]); w.z = pg8::cvt_pk_bf16(v1[0], v1[1]); w.w = pg8::cvt_pk_bf16(v1[2], v1[3]);
                    *(pg8::u32x4*)(rowp + bj * 128) = w;
                }
            }
    }
};
struct EpiDft {
    static constexpr bool PERM = true, AFTER_DRAIN = false;
    bf16* zf;
    __device__ __forceinline__ void operator()(const pg8::f32x4 (&acc)[2][2][4][2], const pg8::Unit& u, int wr, int wc, int fr, int fq) const {
        const int col0 = u.pn * 256 + wc * 32 + 8 * fq;
#pragma unroll
        for (int ai = 0; ai < 2; ++ai)
#pragma unroll
            for (int m = 0; m < 4; ++m) {
                const int tok = u.bz * 2048 + u.pm * 256 + ai * 128 + wr * 64 + m * 16 + fr;
                bf16* rowp = zf + (size_t)tok * 1024 + col0;
#pragma unroll
                for (int bj = 0; bj < 2; ++bj) {
                    const pg8::u32x4 z = *(const pg8::u32x4*)(rowp + bj * 128);
                    const pg8::f32x4 a0 = acc[ai][bj][m][0], a1 = acc[ai][bj][m][1];
                    pg8::u32x4 w;
                    w.x = pg8::cvt_pk_bf16(a0[0] * bflo(z.x), a0[1] * bfhi(z.x)); w.y = pg8::cvt_pk_bf16(a0[2] * bflo(z.y), a0[3] * bfhi(z.y));
                    w.z = pg8::cvt_pk_bf16(a1[0] * bflo(z.z), a1[1] * bfhi(z.z)); w.w = pg8::cvt_pk_bf16(a1[2] * bflo(z.w), a1[3] * bfhi(z.w));
                    *(pg8::u32x4*)(rowp + bj * 128) = w;
                }
            }
    }
};
struct EpiOut {
    static constexpr bool PERM = false, AFTER_DRAIN = true;
    const float* xin; float* xout; bf16* xg; float* ssq; const float* gate; const float* gmodn;
    __device__ __forceinline__ void fused(pg8::f32x4 (&acc)[2][2][4][2], const pg8::Unit& u, int wr, int wc, int fr, int fq, PG8_LAS unsigned char* lds, int wid, int lane) const {
        const int b = u.pm >> 3, col0 = u.pn * 256 + wc * 32 + 4 * fq;
        PG8_LAS float* P = (PG8_LAS float*)lds;
        pg8::f32x4 gt[2][2], gm[2][2];
#pragma unroll
        for (int bj = 0; bj < 2; ++bj)
#pragma unroll
            for (int n = 0; n < 2; ++n) {
                gt[bj][n] = *(const pg8::f32x4*)(gate + (size_t)b * 3072 + col0 + bj * 128 + n * 16);
                gm[bj][n] = gmodn ? *(const pg8::f32x4*)(gmodn + (size_t)b * 1024 + col0 + bj * 128 + n * 16) : (pg8::f32x4){0.f, 0.f, 0.f, 0.f};
            }
#pragma unroll
        for (int ai = 0; ai < 2; ++ai)
#pragma unroll
            for (int m = 0; m < 4; ++m) {
                const int rl = ai * 128 + wr * 64 + m * 16 + fr; const size_t off = (size_t)(u.pm * 256 + rl) * 1024 + col0;
                float s = 0.f;
#pragma unroll
                for (int bj = 0; bj < 2; ++bj)
#pragma unroll
                    for (int n = 0; n < 2; ++n) {
                        const pg8::f32x4 xv = *(const pg8::f32x4*)(xin + off + bj * 128 + n * 16);
                        const pg8::f32x4 o = xv + gt[bj][n] * acc[ai][bj][m][n];
                        *(pg8::f32x4*)(xout + off + bj * 128 + n * 16) = o;
                        s += (o[0] * o[0] + o[1] * o[1]) + (o[2] * o[2] + o[3] * o[3]);
                        if (gmodn) { const pg8::f32x4 h = o * gm[bj][n]; pg8::u32x2 w; w.x = pg8::cvt_pk_bf16(h[0], h[1]); w.y = pg8::cvt_pk_bf16(h[2], h[3]); *(pg8::u32x2*)(xg + off + bj * 128 + n * 16) = w; }
                    }
                s += __shfl_xor(s, 16); s += __shfl_xor(s, 32);
                if (fq == 0) P[rl * 4 + wc] = s;
            }
        asm volatile("s_waitcnt lgkmcnt(0)" ::: "memory"); __builtin_amdgcn_s_barrier(); asm volatile("" ::: "memory");
        const int t = wid * 64 + lane;
        if (t < 256) { const float s = (P[t * 4 + 0] + P[t * 4 + 1]) + (P[t * 4 + 2] + P[t * 4 + 3]); ssq[(size_t)(u.pm * 256 + t) * 4 + u.pn] = s; }
    }
};

struct EpiStore {
    static constexpr bool PERM = true, AFTER_DRAIN = false;
    bf16* O; int ldc;
    __device__ __forceinline__ void operator()(const pg8::f32x4 (&acc)[2][2][4][2], const pg8::Unit& u, int wr, int wc, int fr, int fq) const {
        bf16* base = O + (size_t)u.coff + u.pn * 256 + wc * 32 + 8 * fq;
#pragma unroll
        for (int ai = 0; ai < 2; ++ai)
#pragma unroll
            for (int m = 0; m < 4; ++m) { bf16* rowp = base + (size_t)(u.pm * 256 + ai * 128 + wr * 64 + m * 16 + fr) * ldc;
#pragma unroll
                for (int bj = 0; bj < 2; ++bj) { const pg8::f32x4 v0 = acc[ai][bj][m][0], v1 = acc[ai][bj][m][1];
                    pg8::u32x4 w; w.x = pg8::cvt_pk_bf16(v0[0], v0[1]); w.y = pg8::cvt_pk_bf16(v0[2], v0[3]); w.z = pg8::cvt_pk_bf16(v1[0], v1[1]); w.w = pg8::cvt_pk_bf16(v1[2], v1[3]);
                    *(pg8::u32x4*)(rowp + bj * 128) = w; } }
    }
};

__device__ __forceinline__ void smallm_item(const Frame& F, const float* W, int ldw, int n0, int ncols, const float* bias, float* out, int ldo, LAS float* sv, LAS float* red) {
    const int cg = F.lane & 15, kq = F.lane >> 4, w = F.wave;
    float acc[8][4];
#pragma unroll
    for (int b = 0; b < 8; ++b)
#pragma unroll
        for (int j = 0; j < 4; ++j) acc[b][j] = 0.f;
    const bool ok = (n0 + 4 * cg) < ncols;
    const float* wp = W + (size_t)(128 * w + kq) * ldw + n0 + 4 * cg;
#pragma unroll 4
    for (int s = 0; s < 32; ++s) {
        const int k = 128 * w + 4 * s + kq;
        f32x4 wv = (f32x4){0.f, 0.f, 0.f, 0.f};
        if (ok) wv = *(const f32x4*)(wp + (size_t)(4 * s) * ldw);
        const f32x4 s0 = *(const LAS f32x4*)(sv + k * 8), s1 = *(const LAS f32x4*)(sv + k * 8 + 4);
#pragma unroll
        for (int j = 0; j < 4; ++j) {
            acc[0][j] += s0[0] * wv[j]; acc[1][j] += s0[1] * wv[j]; acc[2][j] += s0[2] * wv[j]; acc[3][j] += s0[3] * wv[j];
            acc[4][j] += s1[0] * wv[j]; acc[5][j] += s1[1] * wv[j]; acc[6][j] += s1[2] * wv[j]; acc[7][j] += s1[3] * wv[j];
        }
    }
#pragma unroll
    for (int b = 0; b < 8; ++b)
#pragma unroll
        for (int j = 0; j < 4; ++j) { float v = acc[b][j]; v += __shfl_xor(v, 16); v += __shfl_xor(v, 32); acc[b][j] = v; }
    if (kq == 0) {
#pragma unroll
        for (int b = 0; b < 8; ++b) *(LAS f32x4*)(red + (w * 8 + b) * 64 + 4 * cg) = (f32x4){acc[b][0], acc[b][1], acc[b][2], acc[b][3]};
    }
    __syncthreads();
    { const int b = F.tid >> 6, c = F.tid & 63; float s = 0.f;
#pragma unroll
      for (int ww = 0; ww < 8; ++ww) s += red[(ww * 8 + b) * 64 + c];
      if (n0 + c < ncols) out[(size_t)b * ldo + n0 + c] = s + (bias ? bias[n0 + c] : 0.f); }
    __syncthreads();
}
__device__ __forceinline__ void transpose_item(const float* W, int ldw, bf16* WT, int ldo, LAS float* scr, int lane) {
#pragma unroll 8
    for (int i = 0; i < 32; ++i) { const int kk = 2 * i + (lane >> 5); scr[kk * 33 + (lane & 31)] = W[(size_t)kk * ldw + (lane & 31)]; }
    LDS_WAIT(); asm volatile("" ::: "memory");
    const int c = lane & 7;
#pragma unroll
    for (int j = 0; j < 4; ++j) { const int n = (lane >> 3) + 8 * j; const LAS float* s = scr + (8 * c) * 33 + n;
        v4u o; o.x = pk2(s[0 * 33], s[1 * 33]); o.y = pk2(s[2 * 33], s[3 * 33]); o.z = pk2(s[4 * 33], s[5 * 33]); o.w = pk2(s[6 * 33], s[7 * 33]);
        *(GAS v4u*)(WT + (size_t)n * ldo + 8 * c) = o; }
    LDS_WAIT(); asm volatile("" ::: "memory");
}

__device__ __forceinline__ void phase_p0(const Frame& F) {
    LAS float* sv = (LAS float*)F.lds;
    LAS float* red = (LAS float*)(F.lds + 32768);
    for (int e = F.tid; e < 8192; e += NTHR) { const int k = e >> 3, b = e & 7; sv[e] = silu_f(F_c[b * 1024 + k]); }
    __syncthreads();
    float* mod = (float*)(F.ws + WS_MOD);
    for (int it = F.vcu; it < 4 * 48; it += F.G) { const int l = it / 48, ch = it % 48;
        smallm_item(F, F_w_ada + (size_t)l * 1024 * 3072, 3072, ch * 64, 3072, F_b_ada + l * 3072, mod + (size_t)l * 8 * 3072, 3072, sv, red); }
    __syncthreads();
    LAS float* scr = (LAS float*)(F.lds + F.wave * 16384);
    const int gw = F.vcu * NWAVES + F.wave, NGW = F.G * NWAVES;
    constexpr int I_IN = 16 * 129, I_OUT = 32 * 32, I_L = I_IN + I_OUT;
    bf16* wtin = (bf16*)(F.ws + WS_WTIN); bf16* wtg = (bf16*)(F.ws + WS_WTG); bf16* wtout = (bf16*)(F.ws + WS_WTOUT);
    for (int it = gw; it < 4 * I_L; it += NGW) {
        const int l = it / I_L; int r = it % I_L;
        if (r < I_IN) { const int kb = r / 129, nb = r % 129; const float* W = F_w_in + (size_t)l * 1024 * DIN + (size_t)(64 * kb) * DIN + 1024 + 32 * nb;
            bf16* WT = (nb < 128) ? wtin + ((size_t)l * NPJ + 2048 + 32 * nb) * 1024 + 64 * kb : wtg + ((size_t)l * 32) * 1024 + 64 * kb;
            transpose_item(W, DIN, WT, 1024, scr, F.lane); }
        else { r -= I_IN; const int kb = r / 32, nb = r % 32; const float* W = F_w_out + (size_t)l * 2048 * 1024 + (size_t)(64 * kb) * 1024 + 32 * nb;
            transpose_item(W, 1024, wtout + ((size_t)l * 1024 + 32 * nb) * 2048 + 64 * kb, 2048, scr, F.lane); }
    }
    { bf16* wft = (bf16*)(F.ws + WS_WFT);
      for (int it = gw; it < 16 * 32; it += NGW) { const int lg = it >> 5, kb = (it >> 3) & 3, nb = it & 7;
          transpose_item(F_w_fmap + (size_t)lg * 65536 + (size_t)(64 * kb) * 256 + 32 * nb, 256, wft + (size_t)lg * 65536 + (size_t)(32 * nb) * 256 + 64 * kb, 256, scr, F.lane); } }
    const int gt = F.vcu * NTHR + F.tid, NGT = F.G * NTHR;
    { bf16* wu = (bf16*)(F.ws + WS_WU);
      for (int e = gt; e < 4 * 1024 * 128; e += NGT) { const int c8 = e & 127, lk = e >> 7; const float* src = F_w_in + (size_t)lk * DIN + 8 * c8;
          const f32x4 a = *(const f32x4*)src, b = *(const f32x4*)(src + 4); v4u w; w.x = pk2(a[0], a[1]); w.y = pk2(a[2], a[3]); w.z = pk2(b[0], b[1]); w.w = pk2(b[2], b[3]);
          *(v4u*)(wu + (size_t)lk * 1024 + 8 * c8) = w; } }
    { unsigned* tr = (unsigned*)(F.ws + WS_TR);
      for (int e = gt; e < 2 * 256 * 128; e += NGT) { const int c2 = (e & 127) * 2, c = (e >> 7) & 255, part = e >> 15; float v[2];
#pragma unroll
          for (int j = 0; j < 2; ++j) { float sn, cs; sincospif((float)((c * (c2 + j)) & 255) * (1.f / 128.f), &sn, &cs); v[j] = (part ? sn : cs) * 0.0625f; }
          tr[e] = pk2(v[0], v[1]); } }
    { bf16* t1 = (bf16*)(F.ws + WS_TM1); bf16* t2 = (bf16*)(F.ws + WS_TM2); unsigned* tw = (unsigned*)(F.ws + WS_TTW);
      for (int e = gt; e < 4096; e += NGT) { const int el = e & 7, ln = (e >> 3) & 63, s4 = (e >> 9) & 3, ri = e >> 11; const int k1 = ln & 31, hh = ln >> 5, p = s4 >> 1, l1 = 16 * (s4 & 1) + 8 * hh + el;
          float sn, cs; sincospif((float)((k1 * l1) & 31) * (1.f / 16.f), &sn, &cs); const float v = ri == 0 ? (p == 0 ? cs : -sn) : (p == 0 ? -sn : -cs); t1[e] = (bf16)f2bf(v); }
      for (int e = gt; e < 8192; e += NGT) { const int el = e & 7, ln = (e >> 3) & 63, sp = (e >> 9) & 1, mt = (e >> 10) & 1, ri = (e >> 11) & 1, mk = e >> 12; const int k2 = 32 * mk + (ln & 31), hh = ln >> 5, l2 = 32 * mt + 16 * sp + 8 * (el >> 2) + 4 * hh + (el & 3);
          float sn, cs; sincospif((float)((k2 * l2) & 63) * (1.f / 32.f), &sn, &cs); t2[e] = (bf16)f2bf((ri == 0 ? cs : sn) * 0.02209708691207961f); }
      for (int e = gt; e < 2048; e += NGT) { const int r3 = e & 3, ln = (e >> 2) & 63, g = (e >> 8) & 3, mt = e >> 10; const int r = 4 * g + r3, l2 = 32 * mt + (r & 3) + 8 * (r >> 2) + 4 * (ln >> 5), k1 = ln & 31;
          float sn, cs; sincospif((float)((l2 * k1) & 2047) * (1.f / 1024.f), &sn, &cs); tw[e] = pk2(cs, sn); } }
}

__device__ __forceinline__ void phase_p1(const Frame& F) {
    const float* mod = (const float*)(F.ws + WS_MOD);
    float* gmod = (float*)(F.ws + WS_GMOD);
    const int gt = F.vcu * NTHR + F.tid, NGT = F.G * NTHR;
    for (int e = gt; e < 4 * 8 * 1024; e += NGT) { const int l = e >> 13, b = (e >> 10) & 7, k = e & 1023; gmod[e] = F_norm_g[l * 1024 + k] * (1.f + mod[((size_t)l * 8 + b) * 3072 + 1024 + k]); }
    const int gw = F.vcu * NWAVES + F.wave, NGW = F.G * NWAVES;
    bf16* xg = (bf16*)(F.ws + WS_XG); float* ssq = (float*)(F.ws + WS_SSQ);
    for (int row = gw; row < MTOK; row += NGW) { const int b = row >> 11; float s = 0.f;
#pragma unroll
        for (int j = 0; j < 4; ++j) { const int k = 4 * F.lane + 256 * j; const f32x4 xv = *(const f32x4*)(F_x + (size_t)row * 1024 + k);
            const f32x4 ng = *(const f32x4*)(F_norm_g + k); const f32x4 sc = *(const f32x4*)(mod + (size_t)b * 3072 + 1024 + k);
            s += (xv[0] * xv[0] + xv[1] * xv[1]) + (xv[2] * xv[2] + xv[3] * xv[3]);
            const f32x4 h = xv * (ng * (sc + 1.f)); v2u w; w.x = pk2(h[0], h[1]); w.y = pk2(h[2], h[3]); *(v2u*)(xg + (size_t)row * 1024 + k) = w; }
#pragma unroll
        for (int o = 1; o < 64; o <<= 1) s += __shfl_xor(s, o);
        if (F.lane == 0) *(f32x4*)(ssq + (size_t)row * 4) = (f32x4){s, 0.f, 0.f, 0.f}; }
    LAS float* sv = (LAS float*)F.lds; LAS float* red = (LAS float*)(F.lds + 32768);
    float* swraw = (float*)(F.ws + WS_SWRAW);
    int curl = -1;
    for (int it = F.vcu; it < 4 * 81; it += F.G) { const int l = it / 81, ch = it % 81;
        if (l != curl) { __syncthreads(); for (int e = F.tid; e < 8192; e += NTHR) { const int k = e >> 3, b = e & 7; sv[e] = mod[((size_t)l * 8 + b) * 3072 + k]; } __syncthreads(); curl = l; }
        smallm_item(F, F_w_in + (size_t)l * 1024 * DIN, DIN, ch * 64, DIN, nullptr, swraw + (size_t)l * 8 * DIN, DIN, sv, red); }
    __syncthreads();
}

__device__ __forceinline__ void phase_p2(const Frame& F) {
    const bf16* wct = (const bf16*)(F.ws + WS_WCT);
    const float* swraw = (const float*)(F.ws + WS_SWRAW); float* sw = (float*)(F.ws + WS_SW);
    const int gw = F.vcu * NWAVES + F.wave, NGW = F.G * NWAVES;
    for (int it = gw; it < 4 * 2048; it += NGW) { const int l = it >> 11, np = it & 2047, part = np >> 10, g = (np >> 8) & 3, d = np & 255, z = (l * 4 + g) * 2 + part;
        const v2u w4 = *(const v2u*)(wct + ((size_t)z * 256 + d) * 256 + 4 * F.lane);
        const float w0 = bflo(w4.x), w1 = bfhi(w4.x), w2 = bflo(w4.y), w3 = bfhi(w4.y);
        float mine = 0.f;
#pragma unroll
        for (int b = 0; b < 8; ++b) { const f32x4 su = *(const f32x4*)(swraw + (size_t)(l * 8 + b) * DIN + g * 256 + 4 * F.lane); float sacc = su[0] * w0 + su[1] * w1 + su[2] * w2 + su[3] * w3;
#pragma unroll
            for (int o = 1; o < 64; o <<= 1) sacc += __shfl_xor(sacc, o);
            mine = (F.lane == b) ? sacc : mine; }
        if (F.lane < 8) sw[(size_t)(l * 8 + F.lane) * NSW + np] = mine; }
    const int gt = F.vcu * NTHR + F.tid, NGT = F.G * NTHR;
    for (int e = gt; e < 4 * 8 * (NSW - 2048); e += NGT) { const int r = e % (NSW - 2048), lb = e / (NSW - 2048), np = 2048 + r;
        sw[(size_t)lb * NSW + np] = (np < NPJ) ? swraw[(size_t)lb * DIN + np - 1024] : swraw[(size_t)lb * DIN + 5120 + (np - NPJ)]; }
}

__device__ __forceinline__ void gate_rows(const Frame& F, int l) {
    const bf16* xg = (const bf16*)(F.ws + WS_XG); const bf16* wtg = (const bf16*)(F.ws + WS_WTG) + (size_t)l * 32 * 1024;
    const float* ssq = (const float*)(F.ws + WS_SSQ); const float* sw = (const float*)(F.ws + WS_SW) + (size_t)l * 8 * NSW; float* glow = (float*)(F.ws + WS_GLOW);
    const int mt = F.wave >> 1, nt = F.wave & 1, fr = F.lane & 15, fq = F.lane >> 4;
    for (int it = F.vcu; it < MTOK / 64; it += F.G) {
        const int row0 = it * 64 + 16 * mt;
        const bf16* ap = xg + (size_t)(row0 + fr) * 1024 + 8 * fq; const bf16* bp = wtg + (size_t)(16 * nt + fr) * 1024 + 8 * fq;
        pg8::f32x4 acc = {0.f, 0.f, 0.f, 0.f};
#pragma unroll 8
        for (int ks = 0; ks < 32; ++ks) { const pg8::bf16x8 a = *(const pg8::bf16x8*)(ap + 32 * ks), b = *(const pg8::bf16x8*)(bp + 32 * ks);
            acc = __builtin_amdgcn_mfma_f32_16x16x32_bf16(a, b, acc, 0, 0, 0); }
        const float bias = sw[(size_t)(row0 >> 11) * NSW + NPJ + 16 * nt + fr];
#pragma unroll
        for (int r = 0; r < 4; ++r) { const int row = row0 + 4 * fq + r; const f32x4 p = *(const f32x4*)(ssq + (size_t)row * 4); const float rs = rsqrtf(((p[0] + p[1]) + (p[2] + p[3])) * (1.f / 1024.f) + EPS);
            glow[(size_t)row * 32 + 16 * nt + fr] = acc[r] * rs + bias; }
    }
}

__host__ __device__ __forceinline__ unsigned off_b(unsigned row, unsigned ch) { return 256u * row + 16u * (ch ^ (((row & 3) << 2) | ((row >> 2) & 3))); }
__host__ __device__ __forceinline__ unsigned off_v(unsigned row, unsigned ch) { return 1024u * (row >> 3) + 512u * (ch >> 2) + 64u * (row & 7) + 16u * ((ch & 3) ^ ((row >> 2) & 3)); }
__device__ __forceinline__ void fourier_ct(const Frame& F) {
    typedef float f32x16 __attribute__((ext_vector_type(16)));
    typedef float f32x8 __attribute__((ext_vector_type(8)));
    typedef short s16x8 __attribute__((ext_vector_type(8)));
    typedef short s16x4 __attribute__((ext_vector_type(4)));
    typedef __bf16 b16x8 __attribute__((ext_vector_type(8)));
    const bf16* abT = (const bf16*)(F.ws + WS_AB); bf16* zf = (bf16*)(F.ws + WS_ZF);
    LAS unsigned char* M2L = F.lds + 131072; LAS unsigned char* TWL = F.lds + 147456;
    const int lane = F.lane, hh = lane >> 5, blk = (lane >> 4) & 1, q4 = (lane & 15) >> 2, p4 = lane & 3;
    for (int e = F.tid; e < 1536; e += NTHR) *(LAS v4u*)(M2L + e * 16) = *(const v4u*)(F.ws + WS_TM2 + (size_t)e * 16);
    s16x8 m1[2][4];
#pragma unroll
    for (int ri = 0; ri < 2; ++ri)
#pragma unroll
        for (int s4 = 0; s4 < 4; ++s4) m1[ri][s4] = *(const s16x8*)(F.ws + WS_TM1 + (size_t)(((ri * 4 + s4) * 64 + lane) * 16));
    __syncthreads();
    for (int it = F.vcu; it < 256; it += F.G) {
        const int b = it >> 5, cb = it & 31;
        const bf16* colbase = abT + (size_t)(b * 1024 + cb * 32 + 4 * F.wave) * 4096;
        LAS unsigned char* slot0 = F.lds + F.wave * 16384;
        unsigned soff[8];
#pragma unroll
        for (int i = 0; i < 8; ++i) { const int p = i >> 2, rowlo = (lane >> 2) & 7, l1 = 8 * (i & 3) + rowlo, ch = 4 * (lane >> 5) + ((lane & 3) ^ ((((i & 3) & 1) << 1) | (rowlo >> 2))); soff[i] = (unsigned)(p * 2048 + l1 * 64 + ch * 8); }
#define CT_ISSUE(j, buf) do { _Pragma("unroll") for (int i_ = 0; i_ < 8; ++i_) \
        __builtin_amdgcn_global_load_lds((const unsigned*)(colbase + (size_t)(j) * 4096 + soff[i_]), (LAS unsigned*)(slot0 + (buf) * 8192 + i_ * 1024), 16, 0, 0); } while (0)
        CT_ISSUE(0, 0); CT_ISSUE(1, 1);
        unsigned outp[2][2][16];
        float hold[2][16];
#pragma unroll
        for (int j = 0; j < 4; ++j) {
            if (j < 3) asm volatile("s_waitcnt vmcnt(8)" ::: "memory"); else asm volatile("s_waitcnt vmcnt(0)" ::: "memory");
            LAS unsigned char* slot = slot0 + (j & 1) * 8192;
            f32x16 acc[2][2];
#pragma unroll
            for (int mt = 0; mt < 2; ++mt)
#pragma unroll
                for (int ri = 0; ri < 2; ++ri)
#pragma unroll
                    for (int r = 0; r < 16; ++r) acc[mt][ri][r] = 0.f;
#pragma unroll
            for (int s4 = 0; s4 < 4; ++s4)
#pragma unroll
                for (int mt = 0; mt < 2; ++mt) {
                    LAS unsigned char* tb = slot + (s4 >> 1) * 4096;
                    const int r0 = 16 * (s4 & 1) + 8 * hh + q4, chn = 4 * mt + 2 * blk + (p4 >> 1);
                    const s16x4 lo = __builtin_amdgcn_ds_read_tr16_b64_v4i16((LAS s16x4*)(tb + off_v(r0, chn) + 8 * (p4 & 1))), hi = __builtin_amdgcn_ds_read_tr16_b64_v4i16((LAS s16x4*)(tb + off_v(r0 + 4, chn) + 8 * (p4 & 1)));
                    const s16x8 a = __builtin_shufflevector(lo, hi, 0, 1, 2, 3, 4, 5, 6, 7);
                    acc[mt][0] = __builtin_amdgcn_mfma_f32_32x32x16_bf16(a, m1[0][s4], acc[mt][0], 0, 0, 0);
                    acc[mt][1] = __builtin_amdgcn_mfma_f32_32x32x16_bf16(a, m1[1][s4], acc[mt][1], 0, 0, 0);
                }
            asm volatile("" ::: "memory");
            if (j + 2 < 4) CT_ISSUE(j + 2, j & 1);
            s16x8 yp[2][2][2];
#pragma unroll
            for (int mt = 0; mt < 2; ++mt) {
                f32x16 yr, yi;
#pragma unroll
                for (int g = 0; g < 4; ++g) { const v4u t4 = *(const LAS v4u*)(TWL + ((mt * 4 + g) * 64 + lane) * 16); const unsigned tt[4] = {t4.x, t4.y, t4.z, t4.w};
#pragma unroll
                    for (int r3 = 0; r3 < 4; ++r3) { const int r = 4 * g + r3; const float c = bflo(tt[r3]), sn = bfhi(tt[r3]); const float a0 = acc[mt][0][r], a1 = acc[mt][1][r];
                        yr[r] = a0 * c + a1 * sn; yi[r] = a1 * c - a0 * sn; } }
#pragma unroll
                for (int sp = 0; sp < 2; ++sp) {
                    const f32x8 v0 = {yr[8 * sp], yr[8 * sp + 1], yr[8 * sp + 2], yr[8 * sp + 3], yr[8 * sp + 4], yr[8 * sp + 5], yr[8 * sp + 6], yr[8 * sp + 7]};
                    const f32x8 v1 = {yi[8 * sp], yi[8 * sp + 1], yi[8 * sp + 2], yi[8 * sp + 3], yi[8 * sp + 4], yi[8 * sp + 5], yi[8 * sp + 6], yi[8 * sp + 7]};
                    yp[0][mt][sp] = __builtin_bit_cast(s16x8, __builtin_convertvector(v0, b16x8)); yp[1][mt][sp] = __builtin_bit_cast(s16x8, __builtin_convertvector(v1, b16x8)); }
            }
#pragma unroll
            for (int mk = 0; mk < 2; ++mk) {
                f32x16 a2;
#pragma unroll
                for (int r = 0; r < 16; ++r) a2[r] = 0.f;
#pragma unroll
                for (int ri = 0; ri < 2; ++ri)
#pragma unroll
                    for (int mt = 0; mt < 2; ++mt)
#pragma unroll
                        for (int sp = 0; sp < 2; ++sp) { const s16x8 mm = *(const LAS s16x8*)(M2L + ((((mk * 2 + ri) * 2 + mt) * 2 + sp) * 64 + lane) * 16);
                            a2 = __builtin_amdgcn_mfma_f32_32x32x16_bf16(mm, yp[ri][mt][sp], a2, 0, 0, 0); }
                if ((j & 1) == 0) {
#pragma unroll
                    for (int r = 0; r < 16; ++r) hold[mk][r] = a2[r];
                } else {
#pragma unroll
                    for (int r = 0; r < 16; ++r) outp[j >> 1][mk][r] = pg8::cvt_pk_bf16(hold[mk][r], a2[r]);
                }
            }
        }
#undef CT_ISSUE
        __syncthreads();
#pragma unroll
        for (int mk = 0; mk < 2; ++mk)
#pragma unroll
            for (int r = 0; r < 16; ++r) { const int lp = (lane & 31) + 32 * (32 * mk + (r & 3) + 8 * (r >> 2) + 4 * hh);
                v2u w; w.x = outp[0][mk][r]; w.y = outp[1][mk][r];
                *(LAS v2u*)(F.lds + lp * 64 + 8 * (F.wave ^ (lp & 7))) = w; }
        __syncthreads();
#pragma unroll 4
        for (int i = 0; i < 16; ++i) { const int e = F.tid + 512 * i, q = e & 3, lp = e >> 2;
            const v4u o = *(const LAS v4u*)(F.lds + lp * 64 + 16 * (q ^ ((lp & 7) >> 1)));
            const unsigned o0 = (lp & 1) ? o.z : o.x, o1 = (lp & 1) ? o.w : o.y, o2 = (lp & 1) ? o.x : o.z, o3 = (lp & 1) ? o.y : o.w;
            bf16* zp = zf + (size_t)(b * 2048 + lp) * 1024 + cb * 32 + 8 * q; const v4u z = *(const v4u*)zp;
            v4u w; w.x = pk2(bflo(o0) * bflo(z.x), bfhi(o0) * bfhi(z.x)); w.y = pk2(bflo(o1) * bflo(z.y), bfhi(o1) * bfhi(z.y));
            w.z = pk2(bflo(o2) * bflo(z.z), bfhi(o2) * bfhi(z.z)); w.w = pk2(bflo(o3) * bflo(z.w), bfhi(o3) * bfhi(z.w));
            *(v4u*)zp = w; }
        __syncthreads();
    }
}

typedef float f32x16 __attribute__((ext_vector_type(16)));
typedef float f32x8 __attribute__((ext_vector_type(8)));
typedef short s16x8 __attribute__((ext_vector_type(8)));
typedef short s16x4 __attribute__((ext_vector_type(4)));
typedef __bf16 b16x8 __attribute__((ext_vector_type(8)));
__device__ __forceinline__ s16x4 tr_rd(LAS unsigned char* p) { return __builtin_amdgcn_ds_read_tr16_b64_v4i16((LAS s16x4*)p); }
__device__ __forceinline__ s16x8 cat8(s16x4 a, s16x4 b) { return __builtin_shufflevector(a, b, 0, 1, 2, 3, 4, 5, 6, 7); }
__device__ __forceinline__ s16x8 pack8(float a0, float a1, float a2, float a3, float a4, float a5, float a6, float a7) {
    const f32x8 v = {a0, a1, a2, a3, a4, a5, a6, a7}; return __builtin_bit_cast(s16x8, __builtin_convertvector(v, b16x8)); }
#define PACK_STEP(x, s) pack8(x[8 * (s)], x[8 * (s) + 1], x[8 * (s) + 2], x[8 * (s) + 3], x[8 * (s) + 4], x[8 * (s) + 5], x[8 * (s) + 6], x[8 * (s) + 7])
#define MFMA32(a, b, c) __builtin_amdgcn_mfma_f32_32x32x16_bf16((a), (b), (c), 0, 0, 0)

__device__ __forceinline__ void gla_prep(const Frame& F, int l) {
    bf16* Q = (bf16*)(F.ws + WS_Q); bf16* Kb = (bf16*)(F.ws + WS_K); bf16* QB = (bf16*)(F.ws + WS_QIB); bf16* KB2 = (bf16*)(F.ws + WS_KIB);
    const float* glow = (const float*)(F.ws + WS_GLOW); float* DEC = (float*)(F.ws + WS_DEC);
    LAS float* gl = (LAS float*)F.lds;
    LAS float* cumL = (LAS float*)(F.lds + 8192);
    const int d1 = F.tid & 127, half = (F.tid >> 7) & 1, dir1 = F.tid >> 8;
    float w[16]; float bias = 0.f; int hcur = -1;
    f32x4 gnx; v4u qnx[2], knx[2];
#define PREP_LOAD(it_) do { const int ch_ = (it_) & 31, h_ = ((it_) >> 5) & 3, b_ = (it_) >> 7; const int tok0_ = b_ * 2048 + ch_ * 64; \
        gnx = *(const f32x4*)(glow + (size_t)tok0_ * 32 + F.tid * 4); \
        _Pragma("unroll") for (int k_ = 0; k_ < 2; ++k_) { const int g_ = F.tid + 512 * k_; const size_t go_ = (size_t)(tok0_ + (g_ >> 4)) * 512 + h_ * 128 + 8 * (g_ & 15); qnx[k_] = *(const v4u*)(Q + go_); knx[k_] = *(const v4u*)(Kb + go_); } } while (0)
    if (F.vcu < 8 * 4 * 32) PREP_LOAD(F.vcu);
    for (int it = F.vcu; it < 8 * 4 * 32; it += F.G) {
        const int ch = it & 31, h = (it >> 5) & 3, b = it >> 7; const int tok0 = b * 2048 + ch * 64;
        if (h != hcur) { const float* wa = (dir1 ? F_w_ab : F_w_af) + (size_t)l * 16 * 512 + h * 128 + d1; bias = (dir1 ? F_b_ab : F_b_af)[l * 512 + h * 128 + d1];
#pragma unroll
            for (int r = 0; r < 16; ++r) w[r] = wa[r * 512];
            hcur = h; }
        __syncthreads();
        *(LAS f32x4*)(gl + F.tid * 4) = gnx;
        v4u qc[2], kc[2];
#pragma unroll
        for (int k = 0; k < 2; ++k) { qc[k] = qnx[k]; kc[k] = knx[k]; }
        __syncthreads();
        if (it + F.G < 8 * 4 * 32) PREP_LOAD(it + F.G);
        { float run = 0.f;
          for (int ii = 0; ii < 32; ++ii) { const int i = half * 32 + ii, pos = dir1 ? 63 - i : i; float z = bias;
#pragma unroll
              for (int r4 = 0; r4 < 4; ++r4) { const f32x4 g = *(const LAS f32x4*)(gl + pos * 32 + dir1 * 16 + 4 * r4); z += g[0] * w[4 * r4] + g[1] * w[4 * r4 + 1] + g[2] * w[4 * r4 + 2] + g[3] * w[4 * r4 + 3]; }
              const float zl = z * 1.4426950408889634f; const float ls = fminf(zl, 0.f) - __builtin_amdgcn_logf(1.f + __builtin_amdgcn_exp2f(-fabsf(zl)));
              run += ls * 0.0625f; cumL[(dir1 * 64 + i) * 128 + d1] = run; } }
        __syncthreads();
        if (F.tid < 256) { const int d = F.tid & 127, dir = F.tid >> 7; const float t0 = cumL[(dir * 64 + 31) * 128 + d]; const float ref = cumL[(dir * 64 + 32) * 128 + d] + t0, last = cumL[(dir * 64 + 63) * 128 + d] + t0;
            float* dp = DEC + ((size_t)(((b * 4 + h) * 2 + dir) * 32 + (dir ? 31 - ch : ch))) * 384 + d;
            dp[0] = __builtin_amdgcn_exp2f(ref); dp[128] = __builtin_amdgcn_exp2f(last); dp[256] = __builtin_amdgcn_exp2f(last - ref); }
#pragma unroll
        for (int k = 0; k < 2; ++k) { const int g = F.tid + 512 * k, pos = g >> 4, dg = g & 15; const size_t go = (size_t)(tok0 + pos) * 512 + h * 128 + 8 * dg;
            const v4u q8 = qc[k], k8 = kc[k];
            float qf[8] = {bflo(q8.x), bfhi(q8.x), bflo(q8.y), bfhi(q8.y), bflo(q8.z), bfhi(q8.z), bflo(q8.w), bfhi(q8.w)};
            float kf[8] = {bflo(k8.x), bfhi(k8.x), bflo(k8.y), bfhi(k8.y), bflo(k8.z), bfhi(k8.z), bflo(k8.w), bfhi(k8.w)};
#pragma unroll
            for (int dir = 0; dir < 2; ++dir) { const int i = dir ? 63 - pos : pos; const LAS float* cb = cumL + dir * 64 * 128 + 8 * dg;
                float qo[8], ko[8];
#pragma unroll
                for (int j4 = 0; j4 < 2; ++j4) { const f32x4 ci = *(const LAS f32x4*)(cb + i * 128 + 4 * j4), c32 = *(const LAS f32x4*)(cb + 32 * 128 + 4 * j4), c31 = *(const LAS f32x4*)(cb + 31 * 128 + 4 * j4);
#pragma unroll
                    for (int j = 0; j < 4; ++j) { const float x = ci[j] - c32[j] - (i < 32 ? c31[j] : 0.f); const float e = __builtin_amdgcn_exp2f(x); qo[4 * j4 + j] = qf[4 * j4 + j] * e; ko[4 * j4 + j] = kf[4 * j4 + j] * __builtin_amdgcn_rcpf(e); } }
                v4u wq, wk; wq.x = pg8::cvt_pk_bf16(qo[0], qo[1]); wq.y = pg8::cvt_pk_bf16(qo[2], qo[3]); wq.z = pg8::cvt_pk_bf16(qo[4], qo[5]); wq.w = pg8::cvt_pk_bf16(qo[6], qo[7]);
                wk.x = pg8::cvt_pk_bf16(ko[0], ko[1]); wk.y = pg8::cvt_pk_bf16(ko[2], ko[3]); wk.z = pg8::cvt_pk_bf16(ko[4], ko[5]); wk.w = pg8::cvt_pk_bf16(ko[6], ko[7]);
                *(v4u*)((dir ? QB : Q) + go) = wq; *(v4u*)((dir ? KB2 : Kb) + go) = wk; } }
    }
#undef PREP_LOAD
    __syncthreads();
}

template <int IB> __device__ __forceinline__ void gla_scan_ib(const Frame& F) {
    const bf16* V = (const bf16*)(F.ws + WS_V); const float* DEC = (const float*)(F.ws + WS_DEC);
    constexpr unsigned QI0 = 0x0000, KI0 = 0x8000, VV0 = 0x10000, DL0 = 0x14000, TT0 = 0x18000;
    const int lane = F.lane, l15 = lane & 15, q = lane >> 4, qq = (lane & 15) >> 2, pp = lane & 3;
    const int m = lane & 31, hh = lane >> 5, blk = (lane >> 4) & 1;
    const int w = F.wave, u = w & 1, t = w >> 1;
    const int qrow0 = F.tid >> 4, qch = F.tid & 15, vrow = F.tid >> 3, vch = F.tid & 7;
    for (int it = F.vcu; it < 256; it += F.G) {
        const int dvs = it & 3, dir = (it >> 2) & 1, h = (it >> 3) & 3, b = it >> 5;
        const bf16* qiG = (const bf16*)(F.ws + (dir ? WS_QIB : WS_Q)); const bf16* kiG = (const bf16*)(F.ws + (dir ? WS_KIB : WS_K));
        bf16* O = (bf16*)(F.ws + (dir ? WS_OB : WS_OF));
        const float* decg = DEC + (size_t)(((b * 4 + h) * 2 + dir) * 32) * 384;
        int zz = 0; asm volatile("" : "+v"(zz));
        unsigned ab[4], abT[4], tpub[4], vaA[2];
#pragma unroll
        for (int s4 = 0; s4 < 4; ++s4) { ab[s4] = off_b(l15 + zz, 4 * s4 + q); abT[s4] = TT0 + 8192u * u + ab[s4]; }
        unsigned kaA0 = off_b(8 * hh + qq + zz, 4 * t + 2 * blk + (pp >> 1)) + 8 * (pp & 1), kaA1 = off_b(8 * hh + qq + 4 + zz, 4 * t + 2 * blk + (pp >> 1)) + 8 * (pp & 1);
        unsigned vbB0 = VV0 + off_v(8 * hh + qq + zz, 4 * u + 2 * blk + (pp >> 1)) + 8 * (pp & 1), vbB1 = VV0 + off_v(8 * hh + qq + 4 + zz, 4 * u + 2 * blk + (pp >> 1)) + 8 * (pp & 1);
#pragma unroll
        for (int mt = 0; mt < 2; ++mt) vaA[mt] = VV0 + off_v(4 * q + qq + zz, 4 * u + 2 * mt + (pp >> 1)) + 8 * (pp & 1);
#pragma unroll
        for (int g = 0; g < 4; ++g) tpub[g] = (TT0 ^ 0x4000u) + 8192u * u + off_b(m + zz, 4 * t + g) + 8 * hh;
        unsigned stQ0 = off_b(qrow0 + zz, qch), stQ1 = off_b(qrow0 + 32 + zz, qch), stV = VV0 + off_v(vrow + zz, vch), stD = DL0 + 16 * F.tid;
        unsigned dlA = DL0 + (32 * t + 4 * hh) * 4;
        f32x16 T;
#pragma unroll
        for (int r = 0; r < 16; ++r) T[r] = 0.f;
        { const v4u z = {0u, 0u, 0u, 0u}; *(LAS v4u*)(F.lds + TT0 + F.tid * 32) = z; *(LAS v4u*)(F.lds + TT0 + F.tid * 32 + 16) = z; }
        v4u qreg[2], kreg[2], vreg; f32x4 dreg = {0.f, 0.f, 0.f, 0.f};
#define GLA_TOK(n, i) (b * 2048 + (dir ? 2047 - ((n) * 64 + (i)) : (n) * 64 + (i)))
#define GLA_LOAD(n) do { _Pragma("unroll") for (int k_ = 0; k_ < 2; ++k_) { const size_t go_ = (size_t)GLA_TOK(n, qrow0 + 32 * k_) * 512 + h * 128 + 8 * qch; qreg[k_] = *(const v4u*)(qiG + go_); kreg[k_] = *(const v4u*)(kiG + go_); } \
        vreg = *(const v4u*)(V + (size_t)GLA_TOK(n, vrow) * 1024 + h * 256 + dvs * 64 + 8 * vch); \
        if (F.tid < 32) dreg = *(const f32x4*)(decg + (size_t)(n) * 384 + 256 + 4 * F.tid); else if (F.tid < 64) dreg = *(const f32x4*)(decg + (size_t)((n) + 1 < 32 ? (n) + 1 : (n)) * 384 + 4 * (F.tid - 32)); } while (0)
        GLA_LOAD(0);
        v2u ost[2] = {{0u, 0u}, {0u, 0u}}; bf16* optr = O;
#pragma nounroll
        for (int n = 0; n < 32; ++n) {
            *(LAS v4u*)(F.lds + QI0 + stQ0) = qreg[0]; *(LAS v4u*)(F.lds + QI0 + stQ1) = qreg[1];
            *(LAS v4u*)(F.lds + KI0 + stQ0) = kreg[0]; *(LAS v4u*)(F.lds + KI0 + stQ1) = kreg[1];
            *(LAS v4u*)(F.lds + stV) = vreg;
            if (F.tid < 64) *(LAS f32x4*)(F.lds + stD) = dreg;
            if (n + 1 < 32) GLA_LOAD(n + 1);
            if (n > 0) { *(v2u*)optr = ost[0]; *(v2u*)(optr + 16) = ost[1]; }
            __syncthreads();
            s16x8 qiB[4], kiA[IB + 1][4], kvA[4], kvB[4], tA[4][2], vA[(IB >> 1) + 1][2];
#pragma unroll
            for (int s4 = 0; s4 < 4; ++s4) qiB[s4] = *(const LAS s16x8*)(F.lds + QI0 + 4096 * IB + ab[s4]);
            if (n + 1 < 32) {
#pragma unroll
                for (int s4 = 0; s4 < 4; ++s4) {
                    kvA[s4] = cat8(tr_rd(F.lds + KI0 + 4096 * s4 + kaA0), tr_rd(F.lds + KI0 + 4096 * s4 + kaA1));
                    kvB[s4] = cat8(tr_rd(F.lds + 2048 * s4 + vbB0), tr_rd(F.lds + 2048 * s4 + vbB1)); }
            }
#pragma unroll
            for (int jt = 0; jt <= IB; ++jt)
#pragma unroll
                for (int s4 = 0; s4 < 4; ++s4) kiA[jt][s4] = *(const LAS s16x8*)(F.lds + KI0 + 4096 * jt + ab[s4]);
            __builtin_amdgcn_sched_barrier(0);
            f32x16 kv;
#pragma unroll
            for (int r = 0; r < 16; ++r) kv[r] = 0.f;
            f32x4 P[4];
#pragma unroll
            for (int jt = 0; jt < 4; ++jt) P[jt] = (f32x4){0.f, 0.f, 0.f, 0.f};
            if (n + 1 < 32) {
#pragma unroll
                for (int s4 = 0; s4 < 4; ++s4) kv = MFMA32(kvA[s4], kvB[s4], kv);
            }
#pragma unroll
            for (int jt = 0; jt <= IB; ++jt) {
#pragma unroll
                for (int s4 = 0; s4 < 4; ++s4) P[jt] = __builtin_amdgcn_mfma_f32_16x16x32_bf16(kiA[jt][s4], qiB[s4], P[jt], 0, 0, 0);
                if (jt == IB) {
#pragma unroll
                    for (int r = 0; r < 4; ++r) { const int jl = 4 * q + r; const bool keep = dir ? (jl < l15) : (jl <= l15); P[jt][r] = keep ? P[jt][r] : 0.f; } }
            }
            __builtin_amdgcn_sched_barrier(0);
#pragma unroll
            for (int s4 = 0; s4 < 4; ++s4)
#pragma unroll
                for (int mt = 0; mt < 2; ++mt) tA[s4][mt] = *(const LAS s16x8*)(F.lds + 4096 * mt + abT[s4]);
#pragma unroll
            for (int a = 0; a <= (IB >> 1); ++a)
#pragma unroll
                for (int mt = 0; mt < 2; ++mt) vA[a][mt] = cat8(tr_rd(F.lds + 4096 * a + vaA[mt]), tr_rd(F.lds + 4096 * a + 2048 + vaA[mt]));
            __builtin_amdgcn_sched_barrier(0);
            f32x4 oacc[2];
#pragma unroll
            for (int mt = 0; mt < 2; ++mt) oacc[mt] = (f32x4){0.f, 0.f, 0.f, 0.f};
#pragma unroll
            for (int s4 = 0; s4 < 4; ++s4)
#pragma unroll
                for (int mt = 0; mt < 2; ++mt) oacc[mt] = __builtin_amdgcn_mfma_f32_16x16x32_bf16(tA[s4][mt], qiB[s4], oacc[mt], 0, 0, 0);
#pragma unroll
            for (int a = 0; a <= (IB >> 1); ++a) {
                const s16x8 pb = pack8(P[2 * a][0], P[2 * a][1], P[2 * a][2], P[2 * a][3], P[2 * a + 1][0], P[2 * a + 1][1], P[2 * a + 1][2], P[2 * a + 1][3]);
#pragma unroll
                for (int mt = 0; mt < 2; ++mt) oacc[mt] = __builtin_amdgcn_mfma_f32_16x16x32_bf16(vA[a][mt], pb, oacc[mt], 0, 0, 0); }
            if (n + 1 < 32) {
#pragma unroll
                for (int g = 0; g < 4; ++g) { const f32x4 el = *(const LAS f32x4*)(F.lds + 32 * g + dlA), er = *(const LAS f32x4*)(F.lds + 512 + 32 * g + dlA);
#pragma unroll
                    for (int j = 0; j < 4; ++j) T[4 * g + j] = (T[4 * g + j] + kv[4 * g + j]) * (el[j] * er[j]);
                    v2u wv; wv.x = pg8::cvt_pk_bf16(T[4 * g], T[4 * g + 1]); wv.y = pg8::cvt_pk_bf16(T[4 * g + 2], T[4 * g + 3]);
                    *(LAS v2u*)(F.lds + tpub[g]) = wv; }
            }
            optr = O + (size_t)GLA_TOK(n, 16 * IB + l15) * 1024 + h * 256 + dvs * 64 + 32 * u + 4 * q;
#pragma unroll
            for (int mt = 0; mt < 2; ++mt) { ost[mt].x = pg8::cvt_pk_bf16(oacc[mt][0], oacc[mt][1]); ost[mt].y = pg8::cvt_pk_bf16(oacc[mt][2], oacc[mt][3]); }
#pragma unroll
            for (int s4 = 0; s4 < 4; ++s4) { ab[s4] ^= 0x4000u; abT[s4] ^= 0x4000u; tpub[s4] ^= 0x4000u; }
            kaA0 ^= 0x4000u; kaA1 ^= 0x4000u; vbB0 ^= 0x2000u; vbB1 ^= 0x2000u; vaA[0] ^= 0x2000u; vaA[1] ^= 0x2000u;
            stQ0 ^= 0x4000u; stQ1 ^= 0x4000u; stV ^= 0x2000u; stD ^= 0x400u; dlA ^= 0x400u;
        }
        *(v2u*)optr = ost[0]; *(v2u*)(optr + 16) = ost[1];
#undef GLA_TOK
#undef GLA_LOAD
        __syncthreads();
    }
}
__device__ __forceinline__ void gla_scan(const Frame& F) {
    const int w = F.wave, ib = (w < 4) ? (w >> 1) : 3 - ((w - 4) >> 1);
    if (ib == 0) gla_scan_ib<0>(F); else if (ib == 1) gla_scan_ib<1>(F); else if (ib == 2) gla_scan_ib<2>(F); else gla_scan_ib<3>(F);
}

__device__ __forceinline__ void gla_finalize(const Frame& F, int l) {
    const bf16* Of = (const bf16*)(F.ws + WS_OF); const bf16* Ob = (const bf16*)(F.ws + WS_OB); bf16* R = (bf16*)(F.ws + WS_R);
    const float* gg = F_gla_g + l * 1024;
    const int gw = F.vcu * NWAVES + F.wave, NGW = F.G * NWAVES;
    for (int tok = gw; tok < MTOK; tok += NGW) {
        const size_t off = (size_t)tok * 1024 + 16 * F.lane;
        float o[16]; float ss = 0.f;
#pragma unroll
        for (int h = 0; h < 2; ++h) { const v4u a = *(const v4u*)(Of + off + 8 * h), c = *(const v4u*)(Ob + off + 8 * h);
            o[8 * h + 0] = bflo(a.x) + bflo(c.x); o[8 * h + 1] = bfhi(a.x) + bfhi(c.x); o[8 * h + 2] = bflo(a.y) + bflo(c.y); o[8 * h + 3] = bfhi(a.y) + bfhi(c.y);
            o[8 * h + 4] = bflo(a.z) + bflo(c.z); o[8 * h + 5] = bfhi(a.z) + bfhi(c.z); o[8 * h + 6] = bflo(a.w) + bflo(c.w); o[8 * h + 7] = bfhi(a.w) + bfhi(c.w); }
#pragma unroll
        for (int j = 0; j < 16; ++j) ss += o[j] * o[j];
        ss += __shfl_xor(ss, 1); ss += __shfl_xor(ss, 2); ss += __shfl_xor(ss, 4); ss += __shfl_xor(ss, 8);
        const float rs = rsqrtf(ss * (1.f / 256.f) + EPS);
#pragma unroll
        for (int h = 0; h < 2; ++h) { const v4u rr = *(const v4u*)(R + off + 8 * h); const f32x4 g0 = *(const f32x4*)(gg + 16 * F.lane + 8 * h), g1 = *(const f32x4*)(gg + 16 * F.lane + 8 * h + 4);
            v4u w;
            w.x = pk2(o[8 * h + 0] * rs * g0[0] * bflo(rr.x), o[8 * h + 1] * rs * g0[1] * bfhi(rr.x)); w.y = pk2(o[8 * h + 2] * rs * g0[2] * bflo(rr.y), o[8 * h + 3] * rs * g0[3] * bfhi(rr.y));
            w.z = pk2(o[8 * h + 4] * rs * g1[0] * bflo(rr.z), o[8 * h + 5] * rs * g1[1] * bfhi(rr.z)); w.w = pk2(o[8 * h + 6] * rs * g1[2] * bflo(rr.w), o[8 * h + 7] * rs * g1[3] * bfhi(rr.w));
            *(v4u*)(R + off + 8 * h) = w; }
    }
}

__device__ __forceinline__ void final_norm(const Frame& F) {
    const float* ssq = (const float*)(F.ws + WS_SSQ);
    const int gw = F.vcu * NWAVES + F.wave, NGW = F.G * NWAVES;
    for (int row = gw; row < MTOK; row += NGW) { const f32x4 p = *(const f32x4*)(ssq + (size_t)row * 4); const float rs = rsqrtf(((p[0] + p[1]) + (p[2] + p[3])) * (1.f / 1024.f) + EPS);
#pragma unroll
        for (int j = 0; j < 4; ++j) { const int k = 4 * F.lane + 256 * j; float* p4 = F.ka->out + (size_t)row * 1024 + k; const f32x4 xv = *(const f32x4*)p4; const f32x4 g = *(const f32x4*)(F_final_g + k);
            *(f32x4*)p4 = xv * rs * g; } }
}

constexpr int N_PRO = 3, PH_PER_LAYER = 5, N_PHASES = N_PRO + DEPTH * PH_PER_LAYER + 1;

__global__ void __launch_bounds__(NTHR, 2) mk_fwd(Args args) {
    extern __shared__ __attribute__((aligned(16))) unsigned char lds[];
    LAS unsigned char* const L = (LAS unsigned char*)lds;
    volatile LAS unsigned* MISC = (volatile LAS unsigned*)(L + MISC_OFF);
    if (threadIdx.x < 32) MISC[threadIdx.x] = 0u;
    __syncthreads();
    const int lo = args.ph_lo, hi = args.ph_hi;
    XcdBarrier bar; bar.bar = (unsigned*)(args.ws + WS_CTL) + CW_BAR; bar.x = 0; bar.st = nullptr;
    if (hi - lo > 1) bar = xcd_barrier_post((unsigned*)(args.ws + WS_CTL) + CW_BAR, MISC + 8);
#define IN(k) (lo <= (k) && (k) < hi)
#define SEAM(k) do { if (IN(k) && IN((k) + 1)) xcd_barrier(bar); } while (0)

    if (IN(0)) { const Frame F = make_frame(L); phase_p0(F); } SEAM(0);
    if (IN(1)) {
        { const Frame F = make_frame(L);
          pg8::Gemm g{(const bf16*)(F.ws + WS_WFT), nullptr, (const bf16*)(F.ws + WS_TR), 256, 256, 256, 4};
          pg8::WcOrder S{F.G, (int)blockIdx.x}; EpiStore E{(bf16*)(F.ws + WS_WCT), 256};
          pg8::gemm_phase<EpiStore, pg8::WcOrder, true>(F.lds, F.tid, g, S, E); }
        { const Frame F = make_frame(L); phase_p1(F); }
    } SEAM(1);
    if (IN(2)) {
        { const Frame F = make_frame(L);
          pg8::Gemm g{(const bf16*)(F.ws + WS_WCT), nullptr, (const bf16*)(F.ws + WS_WU), 256, 256, 1024, 4};
          pg8::FoldOrder S{F.G, (int)blockIdx.x}; EpiStore E{(bf16*)(F.ws + WS_WTIN), 1024};
          pg8::gemm_phase<EpiStore, pg8::FoldOrder, true>(F.lds, F.tid, g, S, E); }
        { const Frame F = make_frame(L); phase_p2(F); }
    } SEAM(2);

    for (int l = 0; l < DEPTH; ++l) {
        const int pb = N_PRO + l * PH_PER_LAYER;
        if (IN(pb + 0)) {
            const bool gate_first = ((blockIdx.x >> 3) & 1) != 0;
            if (gate_first) { const Frame F = make_frame(L); gate_rows(F, l); }
            { const Frame F = make_frame(L);
              const bf16* wtin = (const bf16*)(F.ws + WS_WTIN) + (size_t)l * NPJ * 1024; const float* sw = (const float*)(F.ws + WS_SW) + (size_t)l * 8 * NSW;
              pg8::Gemm g{wtin, nullptr, (const bf16*)(F.ws + WS_XG),  1024, 1024, 1024, 16};
              pg8::StaticOrder S; S.init(2048, MTOK, F.G, (int)blockIdx.x);
              EpiAB E{(const float*)(F.ws + WS_SSQ), sw, (bf16*)(F.ws + WS_AB)};
              pg8::gemm_phase<EpiAB, pg8::StaticOrder, true>(F.lds, F.tid, g, S, E); }
            { const Frame F = make_frame(L);
              const bf16* wtin = (const bf16*)(F.ws + WS_WTIN) + (size_t)l * NPJ * 1024; const float* sw = (const float*)(F.ws + WS_SW) + (size_t)l * 8 * NSW;
              pg8::Gemm g{(const bf16*)(F.ws + WS_XG), nullptr, wtin + (size_t)2048 * 1024,  1024, 1024, 1024, 16};
              pg8::StaticOrder S; S.init(MTOK, 4096, F.G, (int)blockIdx.x);
              EpiProj E{(const float*)(F.ws + WS_SSQ), sw, F.ws};
              pg8::gemm_phase<EpiProj, pg8::StaticOrder, true>(F.lds, F.tid, g, S, E); }
            if (!gate_first) { const Frame F = make_frame(L); gate_rows(F, l); }
        }
        SEAM(pb + 0);
        if (IN(pb + 1)) {
            const Frame F = make_frame(L);
            fourier_ct(F);
            { const Frame F2 = make_frame(L); gla_prep(F2, l); }
        }
        SEAM(pb + 1);
        if (IN(pb + 2)) { const Frame F = make_frame(L); gla_scan(F); }
        SEAM(pb + 2);
        if (IN(pb + 3)) { const Frame F = make_frame(L); gla_finalize(F, l); }
        SEAM(pb + 3);
        if (IN(pb + 4)) {
            const Frame F = make_frame(L);
            const float* mod = (const float*)(F.ws + WS_MOD);
            pg8::Gemm g{(const bf16*)(F.ws + WS_ZF), (const bf16*)(F.ws + WS_R), (const bf16*)(F.ws + WS_WTOUT) + (size_t)l * 1024 * 2048, 2048, 1024, 2048, 16};
            pg8::StaticOrder S; S.init(MTOK, 1024, F.G, (int)blockIdx.x);
            EpiOut E{l == 0 ? F_x : (const float*)F.ka->out, F.ka->out, (bf16*)(F.ws + WS_XG), (float*)(F.ws + WS_SSQ), mod + (size_t)l * 8 * 3072 + 2048,
                     l + 1 < DEPTH ? (const float*)(F.ws + WS_GMOD) + (size_t)(l + 1) * 8 * 1024 : nullptr};
            if (F.G == 256) pg8::gemm_phase<EpiOut, pg8::StaticOrder, false>(F.lds, F.tid, g, S, E);
        }
        SEAM(pb + 4);
    }
    if (IN(N_PHASES - 1)) { const Frame F = make_frame(L); final_norm(F); }
#undef IN
#undef SEAM
}

extern "C" void kernel_launch(void* const* d_in, const int* in_sizes, int n_in, void* d_out, int out_size, void* d_ws, size_t ws_size, hipStream_t stream) {
    static int grid = 0;
    if (grid == 0) {
        if (n_in != 14 || out_size != MTOK * D || ws_size < WS_END) { fprintf(stderr, "kernel_launch: unexpected problem (n_in %d, out %d, ws %zu < %zu)\n", n_in, out_size, ws_size, (size_t)WS_END); grid = -1; return; }
        int dev = 0, cus = 0;
        if (hipGetDevice(&dev) != hipSuccess || hipDeviceGetAttribute(&cus, hipDeviceAttributeMultiprocessorCount, dev) != hipSuccess) { grid = -1; return; }
        if (hipFuncSetAttribute((const void*)mk_fwd, hipFuncAttributeMaxDynamicSharedMemorySize, LDS_BYTES) != hipSuccess) { fprintf(stderr, "kernel_launch: hipFuncSetAttribute failed\n"); grid = -1; return; }
        (void)hipGetLastError();
        grid = cus;
        if (grid != 256) fprintf(stderr, "kernel_launch: %d CUs; built for 256\n", grid);
    }
    if (grid < 0) return;
    (void)hipMemsetAsync((char*)d_ws + WS_CTL, 0, CTL_ZERO_BYTES, stream);
    Args a{};
    for (int i = 0; i < 14; ++i) a.in[i] = (const float*)d_in[i];
    a.out = (float*)d_out; a.ws = (unsigned char*)d_ws;
#if MK_PER_PHASE
    for (int p = 0; p < N_PHASES; ++p) { a.ph_lo = p; a.ph_hi = p + 1; hipLaunchKernelGGL(mk_fwd, dim3(grid), dim3(NTHR), LDS_BYTES, stream, a); }
#else
    a.ph_lo = 0; a.ph_hi = N_PHASES; hipLaunchKernelGGL(mk_fwd, dim3(grid), dim3(NTHR), LDS_BYTES, stream, a);
#endif
}
```

```cpp
#include <hip/hip_runtime.h>
#include <cstdio>
#include <cstdint>

#ifndef MK_PER_PHASE
#define MK_PER_PHASE 0
#endif

namespace pg8 {
#define PG8_LAS __attribute__((address_space(3)))
typedef unsigned short bf16_t;
typedef short bf16x8 __attribute__((ext_vector_type(8)));
typedef float f32x4 __attribute__((ext_vector_type(4)));
typedef unsigned u32x4 __attribute__((ext_vector_type(4)));
typedef unsigned u32x2 __attribute__((ext_vector_type(2)));
constexpr int BM = 256, BK = 64, HALF = 128, HTB = HALF * BK * 2  , STAGE_BYTES = 8 * HTB, NXCD = 8, WGM = 8;

__host__ __device__ __forceinline__ int lds_byte(int r, int c) { const int st = (r >> 4) * 2 + (c >> 5), rr = r & 15, cc = c & 31, ob = rr * 64 + cc * 2; return st * 1024 + (ob ^ (((ob >> 9) & 1) << 5)); }
__host__ __device__ __forceinline__ void stage_rc(int b, int& R, int& C) { const int st = b / 1024, sb = b % 1024, swz = sb ^ (((sb >> 9) & 1) << 5); R = (st >> 1) * 16 + swz / 64; C = (st & 1) * 32 + (swz % 64) / 2; }
__host__ __device__ __forceinline__ int perm32(int rho) { const int n = rho >> 4, i = rho & 15; return 8 * (i >> 2) + 4 * n + (i & 3); }

struct Unit { int pm, pn, bz; unsigned aoff, boff, coff; };
struct Gemm { const bf16_t* A; const bf16_t* A2; const bf16_t* Bt; int K, lda, ldb, ksplit; };

struct StaticOrder {
    int nM, nN, nwg, G, c;
    __host__ __device__ void init(int M, int N, int G_, int c_) { nM = M / BM; nN = N / BM; nwg = nM * nN; G = G_; c = c_; }
    __host__ __device__ bool next(int i, Unit& u) const {
        const long L = (long)i * G + c; if (L >= nwg) return false;
        int wgid = (int)L; { const int q = nwg / NXCD, r = nwg % NXCD, xcd = wgid % NXCD, off = wgid / NXCD; wgid = (xcd < r ? xcd * (q + 1) : r * (q + 1) + (xcd - r) * q) + off; }
        const int nig = WGM * nN, gid = wgid / nig, fm = gid * WGM, gsz = (nM - fm) < WGM ? (nM - fm) : WGM;
        u.pm = fm + ((wgid % nig) % gsz); u.pn = (wgid % nig) / gsz; u.bz = 0; u.aoff = 0u; u.boff = 0u; u.coff = 0u; return true;
    }
};
struct BatchOrder {
    int nM, nN, G, c;
    __host__ __device__ void init(int M, int N, int G_, int c_) { nM = M / BM; nN = N / BM; G = G_; c = c_; }
    __host__ __device__ bool next(int i, Unit& u) const {
        const int per = nM * nN; const long L = (long)i * G + c; if (L >= 8L * per) return false;
        const int bz = (int)(L % 8), t = (int)(L / 8); u.bz = bz; u.pm = t / nN; u.pn = t % nN; u.aoff = 0u; u.boff = (unsigned)bz * (1024u * 4096u * 2u); u.coff = 0u; return true;
    }
};

struct InOrder {
    StaticOrder ab, pj; int G, nab; unsigned offW, offX;
    __host__ __device__ void init(int G_, int c_, unsigned offW_, unsigned offX_) { G = G_; ab.init(2048, 16384, G_, c_); pj.init(16384, 4096, G_, c_); nab = ab.nwg / G_; offW = offW_; offX = offX_; }
    __host__ __device__ bool next(int i, Unit& u) const {
        if (i < nab) { const bool ok = ab.next(i, u); u.bz = 0; u.aoff = offW; u.boff = offX; return ok; }
        const bool ok = pj.next(i - nab, u); u.bz = 1; u.aoff = offX; u.boff = offW + 2048u * 1024u * 2u; return ok;
    }
};
struct WcOrder {
    int G, c;
    __host__ __device__ bool next(int i, Unit& u) const { const int L = i * G + c; if (L >= 32) return false;
        u.pm = 0; u.pn = 0; u.bz = L; u.aoff = (unsigned)(L >> 1) * 131072u; u.boff = (unsigned)(L & 1) * 131072u; u.coff = (unsigned)L * 65536u; return true; }
};
struct FoldOrder {
    int G, c;
    __host__ __device__ bool next(int i, Unit& u) const { const int L = i * G + c; if (L >= 128) return false;
        const int z = L >> 2, part = z & 1, g = (z >> 1) & 3, l = z >> 3;
        u.pm = 0; u.pn = L & 3; u.bz = z; u.aoff = (unsigned)z * 131072u; u.boff = (unsigned)(l * 1048576 + g * 256) * 2u; u.coff = (unsigned)((l * 6144 + part * 1024 + g * 256) * 1024); return true; }
};

typedef float f32x2_t __attribute__((ext_vector_type(2)));
typedef __bf16 b16x2_t __attribute__((ext_vector_type(2)));
__device__ __forceinline__ unsigned cvt_pk_bf16(float lo, float hi) { const f32x2_t v = {lo, hi}; return __builtin_bit_cast(unsigned, __builtin_convertvector(v, b16x2_t)); }

template <class Epi, class Sched, bool ALIGN_EPI>
__device__ __forceinline__ void gemm_phase(PG8_LAS unsigned char* lds, const int tid, const Gemm g, const Sched& S, const Epi& E) {
    const int wid = __builtin_amdgcn_readfirstlane(tid >> 6), lane = tid & 63, wr = wid >> 2, wc = wid & 3, fr = lane & 15, fq = lane >> 4;
    const int K = g.K, nt = K / BK, ks = g.ksplit;
    unsigned voffA[2], voffB[2];
#pragma unroll
    for (int i = 0; i < 2; ++i) { int R, C; stage_rc(tid * 16 + i * 8192, R, C); const int Rb = Epi::PERM ? ((R & ~31) + perm32(R & 31)) : R;
        voffA[i] = (unsigned)(R * g.lda + C) * 2u; voffB[i] = (unsigned)(Rb * g.ldb + C) * 2u; }
    const size_t kstep = (size_t)(BK * 2);
    const size_t hstepA = (size_t)HALF * g.lda * 2, tstepA = 2 * hstepA, hstepB = (size_t)HALF * g.ldb * 2, tstepB = 2 * hstepB;
    const unsigned ldsw = (unsigned)wid * 1024u;
    const int aoff = lds_byte(wr * 64 + fr, fq * 8), boff = lds_byte(wc * 32 + fr, fq * 8);
#define PG8_SA(b, h) (((b) * 2 + (h)) * HTB)
#define PG8_SB(b, h) ((4 + (b) * 2 + (h)) * HTB)
#define PG8_STAGE(bufoff, gbase, voff) do { _Pragma("unroll") for (int _i = 0; _i < 2; ++_i) \
        __builtin_amdgcn_global_load_lds((const unsigned*)((const char*)(gbase) + (voff)[_i]), (PG8_LAS unsigned*)(lds + (bufoff) + ldsw + _i * 8192), 16, 0, 0); } while (0)
#define PG8_LDA(dst, b, h) do { _Pragma("unroll") for (int m = 0; m < 4; ++m) _Pragma("unroll") for (int k = 0; k < 2; ++k) dst[m][k] = *(const PG8_LAS bf16x8*)(lds + PG8_SA(b, h) + aoff + m * 2048 + k * 1024); } while (0)
#define PG8_LDB(dst, b, h) do { _Pragma("unroll") for (int n = 0; n < 2; ++n) _Pragma("unroll") for (int k = 0; k < 2; ++k) dst[n][k] = *(const PG8_LAS bf16x8*)(lds + PG8_SB(b, h) + boff + n * 2048 + k * 1024); } while (0)
#define PG8_MMA(ai, bj, At, Bt) do { __builtin_amdgcn_s_setprio(1); _Pragma("unroll") for (int m = 0; m < 4; ++m) _Pragma("unroll") for (int n = 0; n < 2; ++n) _Pragma("unroll") for (int k = 0; k < 2; ++k) \
        acc[ai][bj][m][n] = __builtin_amdgcn_mfma_f32_16x16x32_bf16(Bt[n][k], At[m][k], acc[ai][bj][m][n], 0, 0, 0); __builtin_amdgcn_s_setprio(0); } while (0)
#define PG8_WAIT_V(n) asm volatile("s_waitcnt vmcnt(" #n ")" ::: "memory")
#define PG8_WAIT_L(n) asm volatile("s_waitcnt lgkmcnt(" #n ")" ::: "memory")
#define PG8_BAR __builtin_amdgcn_s_barrier()
#define PG8_SCHED __builtin_amdgcn_sched_barrier(0)
#define PG8_APT(b1, t) ((b1) + (long long)(t) * (long long)kstep + ((t) >= ks ? d2 : 0ll))
    Unit cur, nxt; int ui = 0;
    if (!S.next(0, cur)) return;
    f32x4 acc[2][2][4][2];
#pragma unroll
    for (int a = 0; a < 2; ++a)
#pragma unroll
        for (int b = 0; b < 2; ++b)
#pragma unroll
            for (int m = 0; m < 4; ++m)
#pragma unroll
                for (int n = 0; n < 2; ++n) acc[a][b][m][n] = (f32x4){0.f, 0.f, 0.f, 0.f};
    bf16x8 At[4][2], B0[2][2], B1[2][2];
    const char* cA = (const char*)g.A + (size_t)cur.aoff + (size_t)cur.pm * tstepA;
    const long long d2 = g.A2 ? ((const char*)g.A2 - (const char*)g.A) - (long long)ks * (long long)kstep : 0ll;
    const char* cB = (const char*)g.Bt + (size_t)cur.boff + (size_t)cur.pn * tstepB;
    PG8_STAGE(PG8_SB(0, 0), cB, voffB); PG8_STAGE(PG8_SB(0, 1), cB + hstepB, voffB); PG8_STAGE(PG8_SA(0, 0), cA, voffA); PG8_STAGE(PG8_SA(0, 1), cA + hstepA, voffA);
    if (wr == 1) PG8_BAR;
    PG8_WAIT_V(2); PG8_BAR;
    PG8_STAGE(PG8_SB(1, 0), cB + kstep, voffB); PG8_STAGE(PG8_SA(1, 0), cA + kstep, voffA); PG8_STAGE(PG8_SB(1, 1), cB + hstepB + kstep, voffB);
    PG8_WAIT_V(6); PG8_BAR;
    for (;;) {
        const bool has_next = S.next(ui + 1, nxt);
        const char* nA = has_next ? (const char*)g.A + (size_t)nxt.aoff + (size_t)nxt.pm * tstepA : cA;
        const char* nB = has_next ? (const char*)g.Bt + (size_t)nxt.boff + (size_t)nxt.pn * tstepB : cB;
#pragma nounroll
        for (int t = 0; t < nt; t += 2) {
            const bool last = (t == nt - 2);
            const char* a1 = PG8_APT(cA, t + 1);
            const char* a2 = last ? nA : PG8_APT(cA, t + 2); const char* b2 = last ? nB : cB + (size_t)(t + 2) * kstep;
            const char* a3 = last ? nA + kstep : PG8_APT(cA, t + 3); const char* b3 = b2 + kstep;
            PG8_LDB(B0, 0, 0); PG8_LDB(B1, 0, 1); PG8_SCHED; PG8_LDA(At, 0, 0); PG8_STAGE(PG8_SA(1, 1), a1 + hstepA, voffA);
            PG8_WAIT_V(8); PG8_WAIT_L(0); PG8_BAR; PG8_MMA(0, 0, At, B0); PG8_MMA(0, 1, At, B1); PG8_BAR; PG8_SCHED;
            PG8_LDA(At, 0, 1); PG8_STAGE(PG8_SB(0, 0), b2, voffB); PG8_STAGE(PG8_SB(0, 1), b2 + hstepB, voffB); PG8_STAGE(PG8_SA(0, 0), a2, voffA);
            PG8_WAIT_V(8); PG8_WAIT_L(0); PG8_BAR; PG8_MMA(1, 0, At, B0); PG8_MMA(1, 1, At, B1); PG8_BAR; PG8_SCHED;
            PG8_LDB(B0, 1, 0); PG8_LDB(B1, 1, 1); PG8_SCHED; PG8_LDA(At, 1, 0); PG8_STAGE(PG8_SA(0, 1), a2 + hstepA, voffA);
            PG8_WAIT_V(8); PG8_WAIT_L(0); PG8_BAR; PG8_MMA(0, 0, At, B0); PG8_MMA(0, 1, At, B1); PG8_BAR; PG8_SCHED;
            PG8_LDA(At, 1, 1); PG8_STAGE(PG8_SB(1, 0), b3, voffB); PG8_STAGE(PG8_SB(1, 1), b3 + hstepB, voffB); PG8_STAGE(PG8_SA(1, 0), a3, voffA);
            PG8_WAIT_V(8); PG8_WAIT_L(0); PG8_BAR; PG8_MMA(1, 0, At, B0); PG8_MMA(1, 1, At, B1); PG8_BAR; PG8_SCHED;
        }
        if constexpr (ALIGN_EPI) { if (wr == 0) PG8_BAR; }
        if constexpr (!Epi::AFTER_DRAIN) { E(acc, cur, wr, wc, fr, fq); }
        if (!has_next) break;
#pragma unroll
        for (int a = 0; a < 2; ++a)
#pragma unroll
            for (int b = 0; b < 2; ++b)
#pragma unroll
                for (int m = 0; m < 4; ++m)
#pragma unroll
                    for (int n = 0; n < 2; ++n) acc[a][b][m][n] = (f32x4){0.f, 0.f, 0.f, 0.f};
        cur = nxt; cA = nA; cB = nB; ++ui;
        if constexpr (ALIGN_EPI) { if (wr == 1) PG8_BAR; }
    }
    PG8_WAIT_V(0);
    if constexpr (!ALIGN_EPI) { if (wr == 0) PG8_BAR; }
    PG8_BAR;
    if constexpr (Epi::AFTER_DRAIN) { E.fused(acc, cur, wr, wc, fr, fq, lds, wid, lane); }
#undef PG8_SA
#undef PG8_SB
#undef PG8_STAGE
#undef PG8_LDA
#undef PG8_LDB
#undef PG8_MMA
#undef PG8_WAIT_V
#undef PG8_WAIT_L
#undef PG8_BAR
#undef PG8_SCHED
#undef PG8_APT
}
}

constexpr int NWAVES = 8, NTHR = NWAVES * 64;
constexpr int D = 1024, BATCH = 8, SEQ = 2048, DEPTH = 4, MTOK = BATCH * SEQ;
constexpr int DIN = 5152;
constexpr int NPJ = 6144;
constexpr int NSW = 6176;
constexpr float EPS = 1e-6f;

constexpr size_t MiB = 1u << 20;
constexpr size_t WS_CTL = 0, CTL_ZERO_BYTES = 65536;
constexpr size_t WS_MOD = 1 * MiB;
constexpr size_t WS_GMOD = WS_MOD + 512 * 1024;
constexpr size_t WS_SWRAW = 2 * MiB;
constexpr size_t WS_SW = 3 * MiB;
constexpr size_t WS_SSQ = 4 * MiB;
constexpr size_t WS_GLOW = WS_SSQ + 512 * 1024;
constexpr size_t WS_WTG = WS_GLOW + 2 * MiB;
constexpr size_t WS_WTIN = 7 * MiB;
constexpr size_t WS_WTOUT = 55 * MiB;
constexpr size_t WS_TM1 = 71 * MiB;
constexpr size_t WS_TM2 = WS_TM1 + 8192;
constexpr size_t WS_TTW = WS_TM2 + 16384;
constexpr size_t WS_XG = 87 * MiB;
constexpr size_t WS_AB = 119 * MiB;
constexpr size_t WS_ZF = 183 * MiB;
constexpr size_t WS_Q = 215 * MiB;
constexpr size_t WS_K = 231 * MiB;
constexpr size_t WS_V = 247 * MiB;
constexpr size_t WS_R = 279 * MiB;
constexpr size_t WS_DEC = 311 * MiB;
constexpr size_t WS_END = 315 * MiB;
constexpr size_t WS_QIB = WS_XG, WS_KIB = WS_XG + 16 * MiB;
constexpr size_t WS_OF = WS_AB, WS_OB = WS_AB + 32 * MiB;
constexpr size_t WS_WFT = WS_AB;
constexpr size_t WS_TR = WS_AB + 2 * MiB;
constexpr size_t WS_WCT = WS_AB + 3 * MiB;
constexpr size_t WS_WU = WS_AB + 8 * MiB;
constexpr int CW_BAR = 4096;

constexpr int LDS_BYTES = 156672;
constexpr int RING_BYTES = 131072;
constexpr int MISC_OFF = 155648 + 320;

#define GAS __attribute__((address_space(1)))
#define LAS __attribute__((address_space(3)))
typedef unsigned short bf16;
typedef unsigned v4u __attribute__((ext_vector_type(4)));
typedef unsigned v2u __attribute__((ext_vector_type(2)));
typedef float f32x4 __attribute__((ext_vector_type(4)));
typedef GAS unsigned gu32;
#define LDS_WAIT() asm volatile("s_waitcnt lgkmcnt(0)" ::: "memory")
__device__ __forceinline__ unsigned f2bf(float f) { unsigned u = __builtin_bit_cast(unsigned, f); return (u + 0x7fffu + ((u >> 16) & 1u)) >> 16; }
__device__ __forceinline__ unsigned pk2(float lo, float hi) { return f2bf(lo) | (f2bf(hi) << 16); }
__device__ __forceinline__ float bflo(unsigned u) { return __builtin_bit_cast(float, u << 16); }
__device__ __forceinline__ float bfhi(unsigned u) { return __builtin_bit_cast(float, u & 0xffff0000u); }
__device__ __forceinline__ float bf2f(bf16 h) { return __builtin_bit_cast(float, (unsigned)h << 16); }
__device__ __forceinline__ float silu_f(float x) { return x / (1.f + __expf(-x)); }
__device__ __forceinline__ float logsig_f(float z) { return fminf(z, 0.f) - log1pf(__expf(-fabsf(z))); }

#define XB_TMO      128
#define XB_XCNT(j)  (256  + 64 * (j))
#define XB_XSUB(j)  (1280 + 64 * (j))
#define XB_XGEN(j)  (2304 + 64 * (j))
#define XB_TOP      3328
#define XB_TOPGEN   3392
#define XCD_BAR_WORDS 3456
#define XB_SPIN_CAP (1u << 18)
__device__ __forceinline__ unsigned xb_ld(unsigned* p)              { return __hip_atomic_load(p, __ATOMIC_RELAXED, __HIP_MEMORY_SCOPE_AGENT); }
__device__ __forceinline__ unsigned xb_add(unsigned* p, unsigned v) { return __hip_atomic_fetch_add(p, v, __ATOMIC_RELAXED, __HIP_MEMORY_SCOPE_AGENT); }
__device__ __forceinline__ unsigned xb_xcc_id() { return (unsigned)__builtin_amdgcn_s_getreg((3 << 11) | 20) & 0xFu; }
#define XB_SPIN(cond, bar) do { unsigned _sp = 0; while (cond) { __builtin_amdgcn_s_sleep(1); \
    if ((++_sp & 255u) == 0u) { if (xb_ld(&(bar)[XB_TMO])) break; if (_sp > XB_SPIN_CAP) { atomicAdd(&(bar)[XB_TMO], 1u); break; } } } } while (0)
struct XcdBarrier { unsigned* bar; unsigned x; volatile LAS unsigned* st; };
__device__ __forceinline__ XcdBarrier xcd_barrier_post(unsigned* bar, volatile LAS unsigned* st) {
    XcdBarrier b; b.bar = bar; b.x = xb_xcc_id(); b.st = st;
    if (threadIdx.x == 0) (void)xb_add(&bar[XB_XCNT(b.x)], 1u);
    return b;
}
__device__ __forceinline__ void xcd_barrier_complete(unsigned* bar, unsigned x, unsigned& nloc, unsigned& nx) {
    const unsigned G = gridDim.x * gridDim.y * gridDim.z;
    unsigned sum, cnt, mine, sp = 0u;
    for (;;) {
        sum = 0u; cnt = 0u; mine = 0u;
#pragma unroll
        for (unsigned j = 0; j < 16; ++j) { const unsigned c = xb_ld(&bar[XB_XCNT(j)]); sum += c; cnt += (c > 0u) ? 1u : 0u; mine = (j == x) ? c : mine; }
        if (sum == G) break;
        __builtin_amdgcn_s_sleep(1);
        if ((++sp & 255u) == 0u) { if (xb_ld(&bar[XB_TMO])) break; if (sp > XB_SPIN_CAP) { atomicAdd(&bar[XB_TMO], 1u); break; } }
    }
    nloc = mine > 0u ? mine : 1u; nx = cnt > 0u ? cnt : 1u;
}
__device__ __forceinline__ void xcd_barrier(const XcdBarrier& b) {
    asm volatile("s_waitcnt vmcnt(0)" ::: "memory");
    __syncthreads();
    if (threadIdx.x == 0) {
        unsigned* bar = b.bar;
        __builtin_amdgcn_s_waitcnt(0);
        unsigned nloc = b.st[0], nx = b.st[1];
        if (nloc == 0u) { xcd_barrier_complete(bar, b.x, nloc, nx); b.st[0] = nloc; b.st[1] = nx; }
        const unsigned old = xb_add(&bar[XB_XSUB(b.x)], 1u);
        const unsigned gen = old / nloc;
        if (old + 1u == (gen + 1u) * nloc) {
            __builtin_amdgcn_fence(__ATOMIC_RELEASE, "agent");
            asm volatile("s_waitcnt vmcnt(0)" ::: "memory");
            const unsigned og = xb_add(&bar[XB_TOP], 1u);
            const unsigned tg = og / nx;
            if (og + 1u == (tg + 1u) * nx) xb_add(&bar[XB_TOPGEN], 1u);
            else XB_SPIN(xb_ld(&bar[XB_TOPGEN]) == tg, bar);
            __builtin_amdgcn_fence(__ATOMIC_ACQUIRE, "agent");
            xb_add(&bar[XB_XGEN(b.x)], 1u);
            asm volatile("s_waitcnt vmcnt(0)" ::: "memory");
        } else {
            XB_SPIN(xb_ld(&bar[XB_XGEN(b.x)]) == gen, bar);
            __builtin_amdgcn_fence(__ATOMIC_ACQUIRE, "agent");
            asm volatile("s_waitcnt vmcnt(0)" ::: "memory");
        }
    }
    __syncthreads();
}

struct Args { const float* in[14]; float* out; unsigned char* ws; int ph_lo, ph_hi; };
typedef const __attribute__((address_space(4))) Args* KArgs;
struct Frame {
    LAS unsigned char* lds;
    int tid, lane, wave, vcu, G;
    KArgs ka; unsigned char* ws;
    __device__ __forceinline__ const float* in(int k) const { return ka->in[k]; }
};
#define F_x F.in(0)
#define F_c F.in(1)
#define F_norm_g F.in(2)
#define F_w_ada F.in(3)
#define F_b_ada F.in(4)
#define F_w_in F.in(5)
#define F_w_fmap F.in(6)
#define F_w_af F.in(7)
#define F_b_af F.in(8)
#define F_w_ab F.in(9)
#define F_b_ab F.in(10)
#define F_gla_g F.in(11)
#define F_w_out F.in(12)
#define F_final_g F.in(13)
__device__ __forceinline__ Frame make_frame(LAS unsigned char* lds) {
    Frame F; F.lds = lds;
    int t = threadIdx.x; asm volatile("" : "+v"(t));
    KArgs ka = (KArgs)__builtin_amdgcn_kernarg_segment_ptr(); asm volatile("" : "+s"(ka));
    F.ka = ka; F.ws = ka->ws;
    F.tid = t; F.lane = t & 63; F.wave = __builtin_amdgcn_readfirstlane(t >> 6);
    F.G = gridDim.x; { const int bx = blockIdx.x; F.vcu = (F.G % 8 == 0) ? (bx % 8) * (F.G / 8) + bx / 8 : bx; }
    return F;
}

struct EpiProj {
    static constexpr bool PERM = true, AFTER_DRAIN = false;
    const float* ssq; const float* sw;
    unsigned char* ws;
    __device__ __forceinline__ void operator()(const pg8::f32x4 (&acc)[2][2][4][2], const pg8::Unit& u, int wr, int wc, int fr, int fq) const {
        const int b = u.pm >> 3, pn = u.pn;
        bf16* dst; int ldc, dcol; int mode;
        if (pn < 4) { dst = (bf16*)(ws + WS_ZF); ldc = 1024; dcol = pn * 256; mode = 1; }
        else if (pn < 6) { dst = (bf16*)(ws + WS_Q); ldc = 512; dcol = (pn - 4) * 256; mode = 2; }
        else if (pn < 8) { dst = (bf16*)(ws + WS_K); ldc = 512; dcol = (pn - 6) * 256; mode = 0; }
        else if (pn < 12) { dst = (bf16*)(ws + WS_V); ldc = 1024; dcol = (pn - 8) * 256; mode = 0; }
        else { dst = (bf16*)(ws + WS_R); ldc = 1024; dcol = (pn - 12) * 256; mode = 1; }
        const int col0 = wc * 32 + 8 * fq;
        pg8::f32x4 bv[2][2];
#pragma unroll
        for (int bj = 0; bj < 2; ++bj)
#pragma unroll
            for (int n = 0; n < 2; ++n) bv[bj][n] = *(const pg8::f32x4*)(sw + (size_t)b * NSW + 2048 + pn * 256 + col0 + bj * 128 + 4 * n);
#pragma unroll
        for (int ai = 0; ai < 2; ++ai)
#pragma unroll
            for (int m = 0; m < 4; ++m) {
                const int row = u.pm * 256 + ai * 128 + wr * 64 + m * 16 + fr;
                const pg8::f32x4 p = *(const pg8::f32x4*)(ssq + (size_t)row * 4);
                const float rs = rsqrtf(((p[0] + p[1]) + (p[2] + p[3])) * (1.f / 1024.f) + EPS);
                bf16* rowp = dst + (size_t)row * ldc + dcol + col0;
#pragma unroll
                for (int bj = 0; bj < 2; ++bj) {
                    pg8::f32x4 v0 = acc[ai][bj][m][0] * rs + bv[bj][0], v1 = acc[ai][bj][m][1] * rs + bv[bj][1];
                    if (mode == 1) {
#pragma unroll
                        for (int j = 0; j < 4; ++j) { v0[j] = silu_f(v0[j]); v1[j] = silu_f(v1[j]); }
                    } else if (mode == 2) { v0 = v0 * 0.08838834764831845f; v1 = v1 * 0.08838834764831845f; }
                    pg8::u32x4 w; w.x = pg8::cvt_pk_bf16(v0[0], v0[1]); w.y = pg8::cvt_pk_bf16(v0[2], v0[3]); w.z = pg8::cvt_pk_bf16(v1[0], v1[1]); w.w = pg8::cvt_pk_bf16(v1[2], v1[3]);
                    *(pg8::u32x4*)(rowp + bj * 128) = w;
                }
            }
    }
};
struct EpiAB {
    static constexpr bool PERM = true, AFTER_DRAIN = false;
    const float* ssq; const float* sw; bf16* abT;
    __device__ __forceinline__ void operator()(const pg8::f32x4 (&acc)[2][2][4][2], const pg8::Unit& u, int wr, int wc, int fr, int fq) const {
        const int b = u.pn >> 3, pos0 = (u.pn & 7) * 256 + wc * 32 + 8 * fq, tok0 = u.pn * 256 + wc * 32 + 8 * fq;
        pg8::f32x4 rs[2][2];
#pragma unroll
        for (int bj = 0; bj < 2; ++bj)
#pragma unroll
            for (int n = 0; n < 2; ++n)
#pragma unroll
                for (int j = 0; j < 4; ++j) {
                    const pg8::f32x4 p = *(const pg8::f32x4*)(ssq + (size_t)(tok0 + bj * 128 + 4 * n + j) * 4);
                    rs[bj][n][j] = rsqrtf(((p[0] + p[1]) + (p[2] + p[3])) * (1.f / 1024.f) + EPS);
                }
#pragma unroll
        for (int ai = 0; ai < 2; ++ai)
#pragma unroll
            for (int m = 0; m < 4; ++m) {
                const int np = u.pm * 256 + ai * 128 + wr * 64 + m * 16 + fr;
                const float bias = sw[(size_t)b * NSW + np];
                bf16* rowp = abT + ((size_t)(b * 1024 + (np & 1023)) * 4096 + (size_t)(np >> 10) * 2048 + pos0);
#pragma unroll
                for (int bj = 0; bj < 2; ++bj) {
                    const pg8::f32x4 v0 = acc[ai][bj][m][0] * rs[bj][0] + bias, v1 = acc[ai][bj][m][1] * rs[bj][1] + bias;
                    pg8::u32x4 w; w.x = pg8::cvt_pk_bf16(v0[0], v0[1]); w.y = pg8::cvt_pk_bf16(v0[2], v0[3]); w.z = pg8::cvt_pk_bf16(v1[0], v1[1]); w.w = pg8::cvt_pk_bf16(v1[2], v1[3]);
                    *(pg8::u32x4*)(rowp + bj * 128) = w;
                }
            }
    }
};
struct EpiIn {
    static constexpr bool PERM = true, AFTER_DRAIN = false;
    EpiAB eab; EpiProj epj;
    __device__ __forceinline__ void operator()(const pg8::f32x4 (&acc)[2][2][4][2], const pg8::Unit& u, int wr, int wc, int fr, int fq) const {
        if (u.bz == 0) eab(acc, u, wr, wc, fr, fq); else epj(acc, u, wr, wc, fr, fq);
    }
};
struct EpiDft {
    static constexpr bool PERM = true, AFTER_DRAIN = false;
    bf16* zf;
    __device__ __forceinline__ void operator()(const pg8::f32x4 (&acc)[2][2][4][2], const pg8::Unit& u, int wr, int wc, int fr, int fq) const {
        const int col0 = u.pn * 256 + wc * 32 + 8 * fq;
#pragma unroll
        for (int ai = 0; ai < 2; ++ai)
#pragma unroll
            for (int m = 0; m < 4; ++m) {
                const int tok = u.bz * 2048 + u.pm * 256 + ai * 128 + wr * 64 + m * 16 + fr;
                bf16* rowp = zf + (size_t)tok * 1024 + col0;
#pragma unroll
                for (int bj = 0; bj < 2; ++bj) {
                    const pg8::u32x4 z = *(const pg8::u32x4*)(rowp + bj * 128);
                    const pg8::f32x4 a0 = acc[ai][bj][m][0], a1 = acc[ai][bj][m][1];
                    pg8::u32x4 w;
                    w.x = pg8::cvt_pk_bf16(a0[0] * bflo(z.x), a0[1] * bfhi(z.x)); w.y = pg8::cvt_pk_bf16(a0[2] * bflo(z.y), a0[3] * bfhi(z.y));
                    w.z = pg8::cvt_pk_bf16(a1[0] * bflo(z.z), a1[1] * bfhi(z.z)); w.w = pg8::cvt_pk_bf16(a1[2] * bflo(z.w), a1[3] * bfhi(z.w));
                    *(pg8::u32x4*)(rowp + bj * 128) = w;
                }
            }
    }
};
struct EpiOut {
    static constexpr bool PERM = false, AFTER_DRAIN = true;
    const float* xin; float* xout; bf16* xg; float* ssq; const float* gate; const float* gmodn;
    __device__ __forceinline__ void fused(pg8::f32x4 (&acc)[2][2][4][2], const pg8::Unit& u, int wr, int wc, int fr, int fq, PG8_LAS unsigned char* lds, int wid, int lane) const {
        const int b = u.pm >> 3, col0 = u.pn * 256 + wc * 32 + 4 * fq;
        PG8_LAS float* P = (PG8_LAS float*)lds;
        pg8::f32x4 gt[2][2], gm[2][2];
#pragma unroll
        for (int bj = 0; bj < 2; ++bj)
#pragma unroll
            for (int n = 0; n < 2; ++n) {
                gt[bj][n] = *(const pg8::f32x4*)(gate + (size_t)b * 3072 + col0 + bj * 128 + n * 16);
                gm[bj][n] = gmodn ? *(const pg8::f32x4*)(gmodn + (size_t)b * 1024 + col0 + bj * 128 + n * 16) : (pg8::f32x4){0.f, 0.f, 0.f, 0.f};
            }
#pragma unroll
        for (int ai = 0; ai < 2; ++ai)
#pragma unroll
            for (int m = 0; m < 4; ++m) {
                const int rl = ai * 128 + wr * 64 + m * 16 + fr; const size_t off = (size_t)(u.pm * 256 + rl) * 1024 + col0;
                float s = 0.f;
#pragma unroll
                for (int bj = 0; bj < 2; ++bj)
#pragma unroll
                    for (int n = 0; n < 2; ++n) {
                        const pg8::f32x4 xv = *(const pg8::f32x4*)(xin + off + bj * 128 + n * 16);
                        const pg8::f32x4 o = xv + gt[bj][n] * acc[ai][bj][m][n];
                        *(pg8::f32x4*)(xout + off + bj * 128 + n * 16) = o;
                        s += (o[0] * o[0] + o[1] * o[1]) + (o[2] * o[2] + o[3] * o[3]);
                        if (gmodn) { const pg8::f32x4 h = o * gm[bj][n]; pg8::u32x2 w; w.x = pg8::cvt_pk_bf16(h[0], h[1]); w.y = pg8::cvt_pk_bf16(h[2], h[3]); *(pg8::u32x2*)(xg + off + bj * 128 + n * 16) = w; }
                    }
                s += __shfl_xor(s, 16); s += __shfl_xor(s, 32);
                if (fq == 0) P[rl * 4 + wc] = s;
            }
        asm volatile("s_waitcnt lgkmcnt(0)" ::: "memory"); __builtin_amdgcn_s_barrier(); asm volatile("" ::: "memory");
        const int t = wid * 64 + lane;
        if (t < 256) { const float s = (P[t * 4 + 0] + P[t * 4 + 1]) + (P[t * 4 + 2] + P[t * 4 + 3]); ssq[(size_t)(u.pm * 256 + t) * 4 + u.pn] = s; }
    }
};

struct EpiStore {
    static constexpr bool PERM = true, AFTER_DRAIN = false;
    bf16* O; int ldc;
    __device__ __forceinline__ void operator()(const pg8::f32x4 (&acc)[2][2][4][2], const pg8::Unit& u, int wr, int wc, int fr, int fq) const {
        bf16* base = O + (size_t)u.coff + u.pn * 256 + wc * 32 + 8 * fq;
#pragma unroll
        for (int ai = 0; ai < 2; ++ai)
#pragma unroll
            for (int m = 0; m < 4; ++m) { bf16* rowp = base + (size_t)(u.pm * 256 + ai * 128 + wr * 64 + m * 16 + fr) * ldc;
#pragma unroll
                for (int bj = 0; bj < 2; ++bj) { const pg8::f32x4 v0 = acc[ai][bj][m][0], v1 = acc[ai][bj][m][1];
                    pg8::u32x4 w; w.x = pg8::cvt_pk_bf16(v0[0], v0[1]); w.y = pg8::cvt_pk_bf16(v0[2], v0[3]); w.z = pg8::cvt_pk_bf16(v1[0], v1[1]); w.w = pg8::cvt_pk_bf16(v1[2], v1[3]);
                    *(pg8::u32x4*)(rowp + bj * 128) = w; } }
    }
};

__device__ __forceinline__ void smallm_item(const Frame& F, const float* W, int ldw, int n0, int ncols, const float* bias, float* out, int ldo, LAS float* sv, LAS float* red) {
    const int cg = F.lane & 15, kq = F.lane >> 4, w = F.wave;
    float acc[8][4];
#pragma unroll
    for (int b = 0; b < 8; ++b)
#pragma unroll
        for (int j = 0; j < 4; ++j) acc[b][j] = 0.f;
    const bool ok = (n0 + 4 * cg) < ncols;
    const float* wp = W + (size_t)(128 * w + kq) * ldw + n0 + 4 * cg;
#pragma unroll 4
    for (int s = 0; s < 32; ++s) {
        const int k = 128 * w + 4 * s + kq;
        f32x4 wv = (f32x4){0.f, 0.f, 0.f, 0.f};
        if (ok) wv = *(const f32x4*)(wp + (size_t)(4 * s) * ldw);
        const f32x4 s0 = *(const LAS f32x4*)(sv + k * 8), s1 = *(const LAS f32x4*)(sv + k * 8 + 4);
#pragma unroll
        for (int j = 0; j < 4; ++j) {
            acc[0][j] += s0[0] * wv[j]; acc[1][j] += s0[1] * wv[j]; acc[2][j] += s0[2] * wv[j]; acc[3][j] += s0[3] * wv[j];
            acc[4][j] += s1[0] * wv[j]; acc[5][j] += s1[1] * wv[j]; acc[6][j] += s1[2] * wv[j]; acc[7][j] += s1[3] * wv[j];
        }
    }
#pragma unroll
    for (int b = 0; b < 8; ++b)
#pragma unroll
        for (int j = 0; j < 4; ++j) { float v = acc[b][j]; v += __shfl_xor(v, 16); v += __shfl_xor(v, 32); acc[b][j] = v; }
    if (kq == 0) {
#pragma unroll
        for (int b = 0; b < 8; ++b) *(LAS f32x4*)(red + (w * 8 + b) * 64 + 4 * cg) = (f32x4){acc[b][0], acc[b][1], acc[b][2], acc[b][3]};
    }
    __syncthreads();
    { const int b = F.tid >> 6, c = F.tid & 63; float s = 0.f;
#pragma unroll
      for (int ww = 0; ww < 8; ++ww) s += red[(ww * 8 + b) * 64 + c];
      if (n0 + c < ncols) out[(size_t)b * ldo + n0 + c] = s + (bias ? bias[n0 + c] : 0.f); }
    __syncthreads();
}
__device__ __forceinline__ void transpose_item(const float* W, int ldw, bf16* WT, int ldo, LAS float* scr, int lane) {
#pragma unroll 8
    for (int i = 0; i < 32; ++i) { const int kk = 2 * i + (lane >> 5); scr[kk * 33 + (lane & 31)] = W[(size_t)kk * ldw + (lane & 31)]; }
    LDS_WAIT(); asm volatile("" ::: "memory");
    const int c = lane & 7;
#pragma unroll
    for (int j = 0; j < 4; ++j) { const int n = (lane >> 3) + 8 * j; const LAS float* s = scr + (8 * c) * 33 + n;
        v4u o; o.x = pk2(s[0 * 33], s[1 * 33]); o.y = pk2(s[2 * 33], s[3 * 33]); o.z = pk2(s[4 * 33], s[5 * 33]); o.w = pk2(s[6 * 33], s[7 * 33]);
        *(GAS v4u*)(WT + (size_t)n * ldo + 8 * c) = o; }
    LDS_WAIT(); asm volatile("" ::: "memory");
}

__device__ __forceinline__ void phase_p0(const Frame& F) {
    LAS float* sv = (LAS float*)F.lds;
    LAS float* red = (LAS float*)(F.lds + 32768);
    for (int e = F.tid; e < 8192; e += NTHR) { const int k = e >> 3, b = e & 7; sv[e] = silu_f(F_c[b * 1024 + k]); }
    __syncthreads();
    float* mod = (float*)(F.ws + WS_MOD);
    for (int it = F.vcu; it < 4 * 48; it += F.G) { const int l = it / 48, ch = it % 48;
        smallm_item(F, F_w_ada + (size_t)l * 1024 * 3072, 3072, ch * 64, 3072, F_b_ada + l * 3072, mod + (size_t)l * 8 * 3072, 3072, sv, red); }
    __syncthreads();
    LAS float* scr = (LAS float*)(F.lds + F.wave * 16384);
    const int gw = F.vcu * NWAVES + F.wave, NGW = F.G * NWAVES;
    constexpr int I_IN = 16 * 129, I_OUT = 32 * 32, I_L = I_IN + I_OUT;
    bf16* wtin = (bf16*)(F.ws + WS_WTIN); bf16* wtg = (bf16*)(F.ws + WS_WTG); bf16* wtout = (bf16*)(F.ws + WS_WTOUT);
    for (int it = gw; it < 4 * I_L; it += NGW) {
        const int l = it / I_L; int r = it % I_L;
        if (r < I_IN) { const int kb = r / 129, nb = r % 129; const float* W = F_w_in + (size_t)l * 1024 * DIN + (size_t)(64 * kb) * DIN + 1024 + 32 * nb;
            bf16* WT = (nb < 128) ? wtin + ((size_t)l * NPJ + 2048 + 32 * nb) * 1024 + 64 * kb : wtg + ((size_t)l * 32) * 1024 + 64 * kb;
            transpose_item(W, DIN, WT, 1024, scr, F.lane); }
        else { r -= I_IN; const int kb = r / 32, nb = r % 32; const float* W = F_w_out + (size_t)l * 2048 * 1024 + (size_t)(64 * kb) * 1024 + 32 * nb;
            transpose_item(W, 1024, wtout + ((size_t)l * 1024 + 32 * nb) * 2048 + 64 * kb, 2048, scr, F.lane); }
    }
    { bf16* wft = (bf16*)(F.ws + WS_WFT);
      for (int it = gw; it < 16 * 32; it += NGW) { const int lg = it >> 5, kb = (it >> 3) & 3, nb = it & 7;
          transpose_item(F_w_fmap + (size_t)lg * 65536 + (size_t)(64 * kb) * 256 + 32 * nb, 256, wft + (size_t)lg * 65536 + (size_t)(32 * nb) * 256 + 64 * kb, 256, scr, F.lane); } }
    const int gt = F.vcu * NTHR + F.tid, NGT = F.G * NTHR;
    { bf16* wu = (bf16*)(F.ws + WS_WU);
      for (int e = gt; e < 4 * 1024 * 128; e += NGT) { const int c8 = e & 127, lk = e >> 7; const float* src = F_w_in + (size_t)lk * DIN + 8 * c8;
          const f32x4 a = *(const f32x4*)src, b = *(const f32x4*)(src + 4); v4u w; w.x = pk2(a[0], a[1]); w.y = pk2(a[2], a[3]); w.z = pk2(b[0], b[1]); w.w = pk2(b[2], b[3]);
          *(v4u*)(wu + (size_t)lk * 1024 + 8 * c8) = w; } }
    { unsigned* tr = (unsigned*)(F.ws + WS_TR);
      for (int e = gt; e < 2 * 256 * 128; e += NGT) { const int c2 = (e & 127) * 2, c = (e >> 7) & 255, part = e >> 15; float v[2];
#pragma unroll
          for (int j = 0; j < 2; ++j) { float sn, cs; sincospif((float)((c * (c2 + j)) & 255) * (1.f / 128.f), &sn, &cs); v[j] = (part ? sn : cs) * 0.0625f; }
          tr[e] = pk2(v[0], v[1]); } }
    { bf16* t1 = (bf16*)(F.ws + WS_TM1); bf16* t2 = (bf16*)(F.ws + WS_TM2); unsigned* tw = (unsigned*)(F.ws + WS_TTW);
      for (int e = gt; e < 4096; e += NGT) { const int el = e & 7, ln = (e >> 3) & 63, s4 = (e >> 9) & 3, ri = e >> 11; const int k1 = ln & 31, hh = ln >> 5, p = s4 >> 1, l1 = 16 * (s4 & 1) + 8 * hh + el;
          float sn, cs; sincospif((float)((k1 * l1) & 31) * (1.f / 16.f), &sn, &cs); const float v = ri == 0 ? (p == 0 ? cs : -sn) : (p == 0 ? -sn : -cs); t1[e] = (bf16)f2bf(v); }
      for (int e = gt; e < 8192; e += NGT) { const int el = e & 7, ln = (e >> 3) & 63, sp = (e >> 9) & 1, mt = (e >> 10) & 1, ri = (e >> 11) & 1, mk = e >> 12; const int k2 = 32 * mk + (ln & 31), hh = ln >> 5, l2 = 32 * mt + 16 * sp + 8 * (el >> 2) + 4 * hh + (el & 3);
          float sn, cs; sincospif((float)((k2 * l2) & 63) * (1.f / 32.f), &sn, &cs); t2[e] = (bf16)f2bf((ri == 0 ? cs : sn) * 0.02209708691207961f); }
      for (int e = gt; e < 2048; e += NGT) { const int r3 = e & 3, ln = (e >> 2) & 63, g = (e >> 8) & 3, mt = e >> 10; const int r = 4 * g + r3, l2 = 32 * mt + (r & 3) + 8 * (r >> 2) + 4 * (ln >> 5), k1 = ln & 31;
          float sn, cs; sincospif((float)((l2 * k1) & 2047) * (1.f / 1024.f), &sn, &cs); tw[e] = pk2(cs, sn); } }
}

__device__ __forceinline__ void phase_p1(const Frame& F) {
    const float* mod = (const float*)(F.ws + WS_MOD);
    float* gmod = (float*)(F.ws + WS_GMOD);
    const int gt = F.vcu * NTHR + F.tid, NGT = F.G * NTHR;
    for (int e = gt; e < 4 * 8 * 1024; e += NGT) { const int l = e >> 13, b = (e >> 10) & 7, k = e & 1023; gmod[e] = F_norm_g[l * 1024 + k] * (1.f + mod[((size_t)l * 8 + b) * 3072 + 1024 + k]); }
    const int gw = F.vcu * NWAVES + F.wave, NGW = F.G * NWAVES;
    bf16* xg = (bf16*)(F.ws + WS_XG); float* ssq = (float*)(F.ws + WS_SSQ);
    for (int row = gw; row < MTOK; row += NGW) { const int b = row >> 11; float s = 0.f;
#pragma unroll
        for (int j = 0; j < 4; ++j) { const int k = 4 * F.lane + 256 * j; const f32x4 xv = *(const f32x4*)(F_x + (size_t)row * 1024 + k);
            const f32x4 ng = *(const f32x4*)(F_norm_g + k); const f32x4 sc = *(const f32x4*)(mod + (size_t)b * 3072 + 1024 + k);
            s += (xv[0] * xv[0] + xv[1] * xv[1]) + (xv[2] * xv[2] + xv[3] * xv[3]);
            const f32x4 h = xv * (ng * (sc + 1.f)); v2u w; w.x = pk2(h[0], h[1]); w.y = pk2(h[2], h[3]); *(v2u*)(xg + (size_t)row * 1024 + k) = w; }
#pragma unroll
        for (int o = 1; o < 64; o <<= 1) s += __shfl_xor(s, o);
        if (F.lane == 0) *(f32x4*)(ssq + (size_t)row * 4) = (f32x4){s, 0.f, 0.f, 0.f}; }
    LAS float* sv = (LAS float*)F.lds; LAS float* red = (LAS float*)(F.lds + 32768);
    float* swraw = (float*)(F.ws + WS_SWRAW);
    int curl = -1;
    for (int it = F.vcu; it < 4 * 81; it += F.G) { const int l = it / 81, ch = it % 81;
        if (l != curl) { __syncthreads(); for (int e = F.tid; e < 8192; e += NTHR) { const int k = e >> 3, b = e & 7; sv[e] = mod[((size_t)l * 8 + b) * 3072 + k]; } __syncthreads(); curl = l; }
        smallm_item(F, F_w_in + (size_t)l * 1024 * DIN, DIN, ch * 64, DIN, nullptr, swraw + (size_t)l * 8 * DIN, DIN, sv, red); }
    __syncthreads();
}

__device__ __forceinline__ void phase_p2(const Frame& F) {
    const bf16* wct = (const bf16*)(F.ws + WS_WCT);
    const float* swraw = (const float*)(F.ws + WS_SWRAW); float* sw = (float*)(F.ws + WS_SW);
    const int gw = F.vcu * NWAVES + F.wave, NGW = F.G * NWAVES;
    for (int it = gw; it < 4 * 2048; it += NGW) { const int l = it >> 11, np = it & 2047, part = np >> 10, g = (np >> 8) & 3, d = np & 255, z = (l * 4 + g) * 2 + part;
        const v2u w4 = *(const v2u*)(wct + ((size_t)z * 256 + d) * 256 + 4 * F.lane);
        const float w0 = bflo(w4.x), w1 = bfhi(w4.x), w2 = bflo(w4.y), w3 = bfhi(w4.y);
        float mine = 0.f;
#pragma unroll
        for (int b = 0; b < 8; ++b) { const f32x4 su = *(const f32x4*)(swraw + (size_t)(l * 8 + b) * DIN + g * 256 + 4 * F.lane); float sacc = su[0] * w0 + su[1] * w1 + su[2] * w2 + su[3] * w3;
#pragma unroll
            for (int o = 1; o < 64; o <<= 1) sacc += __shfl_xor(sacc, o);
            mine = (F.lane == b) ? sacc : mine; }
        if (F.lane < 8) sw[(size_t)(l * 8 + F.lane) * NSW + np] = mine; }
    const int gt = F.vcu * NTHR + F.tid, NGT = F.G * NTHR;
    for (int e = gt; e < 4 * 8 * (NSW - 2048); e += NGT) { const int r = e % (NSW - 2048), lb = e / (NSW - 2048), np = 2048 + r;
        sw[(size_t)lb * NSW + np] = (np < NPJ) ? swraw[(size_t)lb * DIN + np - 1024] : swraw[(size_t)lb * DIN + 5120 + (np - NPJ)]; }
}

__device__ __forceinline__ void gate_rows(const Frame& F, int l) {
    const bf16* xg = (const bf16*)(F.ws + WS_XG); const bf16* wtg = (const bf16*)(F.ws + WS_WTG) + (size_t)l * 32 * 1024;
    const float* ssq = (const float*)(F.ws + WS_SSQ); const float* sw = (const float*)(F.ws + WS_SW) + (size_t)l * 8 * NSW; float* glow = (float*)(F.ws + WS_GLOW);
    const int mt = F.wave >> 1, nt = F.wave & 1, fr = F.lane & 15, fq = F.lane >> 4;
    for (int it = F.vcu; it < MTOK / 64; it += F.G) {
        const int row0 = it * 64 + 16 * mt;
        const bf16* ap = xg + (size_t)(row0 + fr) * 1024 + 8 * fq; const bf16* bp = wtg + (size_t)(16 * nt + fr) * 1024 + 8 * fq;
        pg8::f32x4 acc = {0.f, 0.f, 0.f, 0.f};
#pragma unroll 8
        for (int ks = 0; ks < 32; ++ks) { const pg8::bf16x8 a = *(const pg8::bf16x8*)(ap + 32 * ks), b = *(const pg8::bf16x8*)(bp + 32 * ks);
            acc = __builtin_amdgcn_mfma_f32_16x16x32_bf16(a, b, acc, 0, 0, 0); }
        const float bias = sw[(size_t)(row0 >> 11) * NSW + NPJ + 16 * nt + fr];
#pragma unroll
        for (int r = 0; r < 4; ++r) { const int row = row0 + 4 * fq + r; const f32x4 p = *(const f32x4*)(ssq + (size_t)row * 4); const float rs = rsqrtf(((p[0] + p[1]) + (p[2] + p[3])) * (1.f / 1024.f) + EPS);
            glow[(size_t)row * 32 + 16 * nt + fr] = acc[r] * rs + bias; }
    }
}

__host__ __device__ __forceinline__ unsigned off_b(unsigned row, unsigned ch) { return 256u * row + 16u * (ch ^ (((row & 3) << 2) | ((row >> 2) & 3))); }
__host__ __device__ __forceinline__ unsigned off_v(unsigned row, unsigned ch) { return 1024u * (row >> 3) + 512u * (ch >> 2) + 64u * (row & 7) + 16u * ((ch & 3) ^ ((row >> 2) & 3)); }
__device__ __forceinline__ void fourier_ct(const Frame& F) {
    typedef float f32x16 __attribute__((ext_vector_type(16)));
    typedef float f32x8 __attribute__((ext_vector_type(8)));
    typedef short s16x8 __attribute__((ext_vector_type(8)));
    typedef short s16x4 __attribute__((ext_vector_type(4)));
    typedef __bf16 b16x8 __attribute__((ext_vector_type(8)));
    const bf16* abT = (const bf16*)(F.ws + WS_AB); bf16* zf = (bf16*)(F.ws + WS_ZF);
    LAS unsigned char* M2L = F.lds + 131072; LAS unsigned char* TWL = F.lds + 147456;
    const int lane = F.lane, hh = lane >> 5, blk = (lane >> 4) & 1, q4 = (lane & 15) >> 2, p4 = lane & 3;
    for (int e = F.tid; e < 1536; e += NTHR) *(LAS v4u*)(M2L + e * 16) = *(const v4u*)(F.ws + WS_TM2 + (size_t)e * 16);
    LAS unsigned char* M1L = F.lds + 65536;
    __syncthreads();
    for (int it = F.vcu; it < 256; it += F.G) {
        const int b = it >> 5, cb = it & 31;
        *(LAS v4u*)(M1L + F.tid * 16) = *(const v4u*)(F.ws + WS_TM1 + (size_t)F.tid * 16);
        __syncthreads();
        const bf16* colbase = abT + (size_t)(b * 1024 + cb * 32 + 4 * F.wave) * 4096;
        LAS unsigned char* slot = F.lds + F.wave * 8192;
        const unsigned wlo0 = 512u * ((lane & 7) >> 2) + 64u * (lane >> 3) + 16u * ((lane & 3) ^ ((lane >> 5) & 3)), wlo1 = 512u * ((lane & 7) >> 2) + 64u * (lane >> 3) + 16u * ((lane & 3) ^ ((2 + (lane >> 5)) & 3));
        v4u inr[8];
#define CT_LOAD(j) do { _Pragma("unroll") for (int i_ = 0; i_ < 8; ++i_) inr[i_] = *(const v4u*)(colbase + (size_t)(j) * 4096 + (lane + 64 * i_) * 8); } while (0)
#define CT_WRITE() do { _Pragma("unroll") for (int i_ = 0; i_ < 8; ++i_) *(LAS v4u*)(slot + 4096 * (i_ >> 2) + 1024 * (i_ & 3) + ((i_ & 1) ? wlo1 : wlo0)) = inr[i_]; } while (0)
        CT_LOAD(0);
        unsigned outp[2][2][16];
#pragma unroll
        for (int j = 0; j < 4; ++j) {
            CT_WRITE();
            if (j + 1 < 4) CT_LOAD(j + 1);
            f32x16 acc[2][2];
#pragma unroll
            for (int mt = 0; mt < 2; ++mt)
#pragma unroll
                for (int ri = 0; ri < 2; ++ri)
#pragma unroll
                    for (int r = 0; r < 16; ++r) acc[mt][ri][r] = 0.f;
#pragma unroll
            for (int s4 = 0; s4 < 4; ++s4)
#pragma unroll
                for (int mt = 0; mt < 2; ++mt) {
                    LAS unsigned char* tb = slot + (s4 >> 1) * 4096;
                    const int r0 = 16 * (s4 & 1) + 8 * hh + q4, chn = 4 * mt + 2 * blk + (p4 >> 1);
                    const s16x4 lo = __builtin_amdgcn_ds_read_tr16_b64_v4i16((LAS s16x4*)(tb + off_v(r0, chn) + 8 * (p4 & 1))), hi = __builtin_amdgcn_ds_read_tr16_b64_v4i16((LAS s16x4*)(tb + off_v(r0 + 4, chn) + 8 * (p4 & 1)));
                    const s16x8 a = __builtin_shufflevector(lo, hi, 0, 1, 2, 3, 4, 5, 6, 7);
                    acc[mt][0] = __builtin_amdgcn_mfma_f32_32x32x16_bf16(a, *(const LAS s16x8*)(M1L + ((0 * 4 + s4) * 64 + lane) * 16), acc[mt][0], 0, 0, 0);
                    acc[mt][1] = __builtin_amdgcn_mfma_f32_32x32x16_bf16(a, *(const LAS s16x8*)(M1L + ((1 * 4 + s4) * 64 + lane) * 16), acc[mt][1], 0, 0, 0);
                }
            s16x8 yp[2][2][2];
#pragma unroll
            for (int mt = 0; mt < 2; ++mt) {
                f32x16 yr, yi;
#pragma unroll
                for (int g = 0; g < 4; ++g) { const v4u t4 = *(const LAS v4u*)(TWL + ((mt * 4 + g) * 64 + lane) * 16); const unsigned tt[4] = {t4.x, t4.y, t4.z, t4.w};
#pragma unroll
                    for (int r3 = 0; r3 < 4; ++r3) { const int r = 4 * g + r3; const float c = bflo(tt[r3]), sn = bfhi(tt[r3]); const float a0 = acc[mt][0][r], a1 = acc[mt][1][r];
                        yr[r] = a0 * c + a1 * sn; yi[r] = a1 * c - a0 * sn; } }
#pragma unroll
                for (int sp = 0; sp < 2; ++sp) {
                    const f32x8 v0 = {yr[8 * sp], yr[8 * sp + 1], yr[8 * sp + 2], yr[8 * sp + 3], yr[8 * sp + 4], yr[8 * sp + 5], yr[8 * sp + 6], yr[8 * sp + 7]};
                    const f32x8 v1 = {yi[8 * sp], yi[8 * sp + 1], yi[8 * sp + 2], yi[8 * sp + 3], yi[8 * sp + 4], yi[8 * sp + 5], yi[8 * sp + 6], yi[8 * sp + 7]};
                    yp[0][mt][sp] = __builtin_bit_cast(s16x8, __builtin_convertvector(v0, b16x8)); yp[1][mt][sp] = __builtin_bit_cast(s16x8, __builtin_convertvector(v1, b16x8)); }
            }
#pragma unroll
            for (int mk = 0; mk < 2; ++mk) {
                f32x16 a2;
#pragma unroll
                for (int r = 0; r < 16; ++r) a2[r] = 0.f;
#pragma unroll
                for (int ri = 0; ri < 2; ++ri)
#pragma unroll
                    for (int mt = 0; mt < 2; ++mt)
#pragma unroll
                        for (int sp = 0; sp < 2; ++sp) { const s16x8 mm = *(const LAS s16x8*)(M2L + ((((mk * 2 + ri) * 2 + mt) * 2 + sp) * 64 + lane) * 16);
                            a2 = __builtin_amdgcn_mfma_f32_32x32x16_bf16(mm, yp[ri][mt][sp], a2, 0, 0, 0); }
                if ((j & 1) == 0) {
#pragma unroll
                    for (int r = 0; r < 16; ++r) outp[j >> 1][mk][r] = pg8::cvt_pk_bf16(a2[r], 0.f);
                } else {
#pragma unroll
                    for (int r = 0; r < 16; ++r) outp[j >> 1][mk][r] |= pg8::cvt_pk_bf16(0.f, a2[r]);
                }
            }
        }
#undef CT_LOAD
#undef CT_WRITE
        __syncthreads();
#pragma unroll
        for (int mk = 0; mk < 2; ++mk)
#pragma unroll
            for (int r = 0; r < 16; ++r) { const int lp = (lane & 31) + 32 * (32 * mk + (r & 3) + 8 * (r >> 2) + 4 * hh);
                v2u w; w.x = outp[0][mk][r]; w.y = outp[1][mk][r];
                *(LAS v2u*)(F.lds + lp * 64 + 8 * (F.wave ^ (lp & 7))) = w; }
        __syncthreads();
#pragma nounroll
        for (int i0 = 0; i0 < 16; i0 += 8) {
        v4u zr[8];
#pragma unroll
        for (int i = 0; i < 8; ++i) { const int e = F.tid + 512 * (i0 + i), q = e & 3, lp = e >> 2; zr[i] = *(const v4u*)(zf + (size_t)(b * 2048 + lp) * 1024 + cb * 32 + 8 * q); }
#pragma unroll
        for (int i = 0; i < 8; ++i) { const int e = F.tid + 512 * (i0 + i), q = e & 3, lp = e >> 2;
            const v4u o = *(const LAS v4u*)(F.lds + lp * 64 + 16 * (q ^ ((lp & 7) >> 1)));
            const unsigned o0 = (lp & 1) ? o.z : o.x, o1 = (lp & 1) ? o.w : o.y, o2 = (lp & 1) ? o.x : o.z, o3 = (lp & 1) ? o.y : o.w;
            bf16* zp = zf + (size_t)(b * 2048 + lp) * 1024 + cb * 32 + 8 * q; const v4u z = zr[i];
            v4u w; w.x = pk2(bflo(o0) * bflo(z.x), bfhi(o0) * bfhi(z.x)); w.y = pk2(bflo(o1) * bflo(z.y), bfhi(o1) * bfhi(z.y));
            w.z = pk2(bflo(o2) * bflo(z.z), bfhi(o2) * bfhi(z.z)); w.w = pk2(bflo(o3) * bflo(z.w), bfhi(o3) * bfhi(z.w));
            *(v4u*)zp = w; }
        }
        __syncthreads();
    }
}

typedef float f32x16 __attribute__((ext_vector_type(16)));
typedef float f32x8 __attribute__((ext_vector_type(8)));
typedef short s16x8 __attribute__((ext_vector_type(8)));
typedef short s16x4 __attribute__((ext_vector_type(4)));
typedef __bf16 b16x8 __attribute__((ext_vector_type(8)));
__device__ __forceinline__ s16x4 tr_rd(LAS unsigned char* p) { return __builtin_amdgcn_ds_read_tr16_b64_v4i16((LAS s16x4*)p); }
__device__ __forceinline__ s16x8 cat8(s16x4 a, s16x4 b) { return __builtin_shufflevector(a, b, 0, 1, 2, 3, 4, 5, 6, 7); }
__device__ __forceinline__ s16x8 pack8(float a0, float a1, float a2, float a3, float a4, float a5, float a6, float a7) {
    const f32x8 v = {a0, a1, a2, a3, a4, a5, a6, a7}; return __builtin_bit_cast(s16x8, __builtin_convertvector(v, b16x8)); }
#define PACK_STEP(x, s) pack8(x[8 * (s)], x[8 * (s) + 1], x[8 * (s) + 2], x[8 * (s) + 3], x[8 * (s) + 4], x[8 * (s) + 5], x[8 * (s) + 6], x[8 * (s) + 7])
#define MFMA32(a, b, c) __builtin_amdgcn_mfma_f32_32x32x16_bf16((a), (b), (c), 0, 0, 0)

__device__ __forceinline__ void gla_prep(const Frame& F, int l) {
    bf16* Q = (bf16*)(F.ws + WS_Q); bf16* Kb = (bf16*)(F.ws + WS_K); bf16* QB = (bf16*)(F.ws + WS_QIB); bf16* KB2 = (bf16*)(F.ws + WS_KIB);
    const float* glow = (const float*)(F.ws + WS_GLOW); float* DEC = (float*)(F.ws + WS_DEC);
    LAS float* gl = (LAS float*)F.lds;
    LAS float* cumL = (LAS float*)(F.lds + 8192);
    const int d1 = F.tid & 127, half = (F.tid >> 7) & 1, dir1 = F.tid >> 8;
    float w[16]; float bias = 0.f; int hcur = -1;
    f32x4 gnx; v4u qnx[2], knx[2];
#define PREP_LOAD(it_) do { const int ch_ = (it_) & 31, h_ = ((it_) >> 5) & 3, b_ = (it_) >> 7; const int tok0_ = b_ * 2048 + ch_ * 64; \
        gnx = *(const f32x4*)(glow + (size_t)tok0_ * 32 + F.tid * 4); \
        _Pragma("unroll") for (int k_ = 0; k_ < 2; ++k_) { const int g_ = F.tid + 512 * k_; const size_t go_ = (size_t)(tok0_ + (g_ >> 4)) * 512 + h_ * 128 + 8 * (g_ & 15); qnx[k_] = *(const v4u*)(Q + go_); knx[k_] = *(const v4u*)(Kb + go_); } } while (0)
    if (F.vcu < 8 * 4 * 32) PREP_LOAD(F.vcu);
    for (int it = F.vcu; it < 8 * 4 * 32; it += F.G) {
        const int ch = it & 31, h = (it >> 5) & 3, b = it >> 7; const int tok0 = b * 2048 + ch * 64;
        if (h != hcur) { const float* wa = (dir1 ? F_w_ab : F_w_af) + (size_t)l * 16 * 512 + h * 128 + d1; bias = (dir1 ? F_b_ab : F_b_af)[l * 512 + h * 128 + d1];
#pragma unroll
            for (int r = 0; r < 16; ++r) w[r] = wa[r * 512];
            hcur = h; }
        __syncthreads();
        *(LAS f32x4*)(gl + F.tid * 4) = gnx;
        v4u qc[2], kc[2];
#pragma unroll
        for (int k = 0; k < 2; ++k) { qc[k] = qnx[k]; kc[k] = knx[k]; }
        __syncthreads();
        if (it + F.G < 8 * 4 * 32) PREP_LOAD(it + F.G);
        { float run = 0.f;
          for (int ii = 0; ii < 32; ++ii) { const int i = half * 32 + ii, pos = dir1 ? 63 - i : i; float z = bias;
#pragma unroll
              for (int r4 = 0; r4 < 4; ++r4) { const f32x4 g = *(const LAS f32x4*)(gl + pos * 32 + dir1 * 16 + 4 * r4); z += g[0] * w[4 * r4] + g[1] * w[4 * r4 + 1] + g[2] * w[4 * r4 + 2] + g[3] * w[4 * r4 + 3]; }
              const float zl = z * 1.4426950408889634f; const float ls = fminf(zl, 0.f) - __builtin_amdgcn_logf(1.f + __builtin_amdgcn_exp2f(-fabsf(zl)));
              run += ls * 0.0625f; cumL[(dir1 * 64 + i) * 128 + d1] = run; } }
        __syncthreads();
        if (F.tid < 256) { const int d = F.tid & 127, dir = F.tid >> 7; const float t0 = cumL[(dir * 64 + 31) * 128 + d]; const float ref = cumL[(dir * 64 + 32) * 128 + d] + t0, last = cumL[(dir * 64 + 63) * 128 + d] + t0;
            float* dp = DEC + ((size_t)(((b * 4 + h) * 2 + dir) * 32 + (dir ? 31 - ch : ch))) * 384 + d;
            dp[0] = __builtin_amdgcn_exp2f(ref); dp[128] = __builtin_amdgcn_exp2f(last); dp[256] = __builtin_amdgcn_exp2f(last - ref); }
#pragma unroll
        for (int k = 0; k < 2; ++k) { const int g = F.tid + 512 * k, pos = g >> 4, dg = g & 15; const size_t go = (size_t)(tok0 + pos) * 512 + h * 128 + 8 * dg;
            const v4u q8 = qc[k], k8 = kc[k];
            float qf[8] = {bflo(q8.x), bfhi(q8.x), bflo(q8.y), bfhi(q8.y), bflo(q8.z), bfhi(q8.z), bflo(q8.w), bfhi(q8.w)};
            float kf[8] = {bflo(k8.x), bfhi(k8.x), bflo(k8.y), bfhi(k8.y), bflo(k8.z), bfhi(k8.z), bflo(k8.w), bfhi(k8.w)};
#pragma unroll
            for (int dir = 0; dir < 2; ++dir) { const int i = dir ? 63 - pos : pos; const LAS float* cb = cumL + dir * 64 * 128 + 8 * dg;
                float qo[8], ko[8];
#pragma unroll
                for (int j4 = 0; j4 < 2; ++j4) { const f32x4 ci = *(const LAS f32x4*)(cb + i * 128 + 4 * j4), c32 = *(const LAS f32x4*)(cb + 32 * 128 + 4 * j4), c31 = *(const LAS f32x4*)(cb + 31 * 128 + 4 * j4);
#pragma unroll
                    for (int j = 0; j < 4; ++j) { const float x = ci[j] - c32[j] - (i < 32 ? c31[j] : 0.f); const float e = __builtin_amdgcn_exp2f(x); qo[4 * j4 + j] = qf[4 * j4 + j] * e; ko[4 * j4 + j] = kf[4 * j4 + j] * __builtin_amdgcn_rcpf(e); } }
                v4u wq, wk; wq.x = pg8::cvt_pk_bf16(qo[0], qo[1]); wq.y = pg8::cvt_pk_bf16(qo[2], qo[3]); wq.z = pg8::cvt_pk_bf16(qo[4], qo[5]); wq.w = pg8::cvt_pk_bf16(qo[6], qo[7]);
                wk.x = pg8::cvt_pk_bf16(ko[0], ko[1]); wk.y = pg8::cvt_pk_bf16(ko[2], ko[3]); wk.z = pg8::cvt_pk_bf16(ko[4], ko[5]); wk.w = pg8::cvt_pk_bf16(ko[6], ko[7]);
                *(v4u*)((dir ? QB : Q) + go) = wq; *(v4u*)((dir ? KB2 : Kb) + go) = wk; } }
    }
#undef PREP_LOAD
    __syncthreads();
}

template <int IB> __device__ __forceinline__ void gla_scan_ib(const Frame& F) {
    const bf16* V = (const bf16*)(F.ws + WS_V); const float* DEC = (const float*)(F.ws + WS_DEC);
    constexpr unsigned QI0 = 0x0000, KI0 = 0x8000, VV0 = 0x10000, DL0 = 0x14000, TT0 = 0x18000;
    const int lane = F.lane, l15 = lane & 15, q = lane >> 4, qq = (lane & 15) >> 2, pp = lane & 3;
    const int m = lane & 31, hh = lane >> 5, blk = (lane >> 4) & 1;
    const int w = F.wave, u = w & 1, t = w >> 1;
    const int qrow0 = F.tid >> 4, qch = F.tid & 15, vrow = F.tid >> 3, vch = F.tid & 7;
    for (int it = F.vcu; it < 256; it += F.G) {
        const int dvs = it & 3, dir = (it >> 2) & 1, h = (it >> 3) & 3, b = it >> 5;
        const bf16* qiG = (const bf16*)(F.ws + (dir ? WS_QIB : WS_Q)); const bf16* kiG = (const bf16*)(F.ws + (dir ? WS_KIB : WS_K));
        bf16* O = (bf16*)(F.ws + (dir ? WS_OB : WS_OF));
        const float* decg = DEC + (size_t)(((b * 4 + h) * 2 + dir) * 32) * 384;
        int zz = 0; asm volatile("" : "+v"(zz));
        unsigned ab[4], abT[4], tpub[4], vaA[2];
#pragma unroll
        for (int s4 = 0; s4 < 4; ++s4) { ab[s4] = off_b(l15 + zz, 4 * s4 + q); abT[s4] = TT0 + 8192u * u + ab[s4]; }
        unsigned kaA0 = off_b(8 * hh + qq + zz, 4 * t + 2 * blk + (pp >> 1)) + 8 * (pp & 1), kaA1 = off_b(8 * hh + qq + 4 + zz, 4 * t + 2 * blk + (pp >> 1)) + 8 * (pp & 1);
        unsigned vbB0 = VV0 + off_v(8 * hh + qq + zz, 4 * u + 2 * blk + (pp >> 1)) + 8 * (pp & 1), vbB1 = VV0 + off_v(8 * hh + qq + 4 + zz, 4 * u + 2 * blk + (pp >> 1)) + 8 * (pp & 1);
#pragma unroll
        for (int mt = 0; mt < 2; ++mt) vaA[mt] = VV0 + off_v(4 * q + qq + zz, 4 * u + 2 * mt + (pp >> 1)) + 8 * (pp & 1);
#pragma unroll
        for (int g = 0; g < 4; ++g) tpub[g] = (TT0 ^ 0x4000u) + 8192u * u + off_b(m + zz, 4 * t + g) + 8 * hh;
        unsigned stQ0 = off_b(qrow0 + zz, qch), stQ1 = off_b(qrow0 + 32 + zz, qch), stV = VV0 + off_v(vrow + zz, vch), stD = DL0 + 16 * F.tid;
        unsigned dlA = DL0 + (32 * t + 4 * hh) * 4;
        f32x16 T;
#pragma unroll
        for (int r = 0; r < 16; ++r) T[r] = 0.f;
        { const v4u z = {0u, 0u, 0u, 0u}; *(LAS v4u*)(F.lds + TT0 + F.tid * 32) = z; *(LAS v4u*)(F.lds + TT0 + F.tid * 32 + 16) = z; }
        v4u qreg[2], kreg[2], vreg; f32x4 dreg = {0.f, 0.f, 0.f, 0.f};
#define GLA_TOK(n, i) (b * 2048 + (dir ? 2047 - ((n) * 64 + (i)) : (n) * 64 + (i)))
#define GLA_LOAD(n) do { _Pragma("unroll") for (int k_ = 0; k_ < 2; ++k_) { const size_t go_ = (size_t)GLA_TOK(n, qrow0 + 32 * k_) * 512 + h * 128 + 8 * qch; qreg[k_] = *(const v4u*)(qiG + go_); kreg[k_] = *(const v4u*)(kiG + go_); } \
        vreg = *(const v4u*)(V + (size_t)GLA_TOK(n, vrow) * 1024 + h * 256 + dvs * 64 + 8 * vch); \
        if (F.tid < 32) dreg = *(const f32x4*)(decg + (size_t)(n) * 384 + 256 + 4 * F.tid); else if (F.tid < 64) dreg = *(const f32x4*)(decg + (size_t)((n) + 1 < 32 ? (n) + 1 : (n)) * 384 + 4 * (F.tid - 32)); } while (0)
        GLA_LOAD(0);
        v2u ost[2] = {{0u, 0u}, {0u, 0u}}; bf16* optr = O;
#pragma nounroll
        for (int n = 0; n < 32; ++n) {
            *(LAS v4u*)(F.lds + QI0 + stQ0) = qreg[0]; *(LAS v4u*)(F.lds + QI0 + stQ1) = qreg[1];
            *(LAS v4u*)(F.lds + KI0 + stQ0) = kreg[0]; *(LAS v4u*)(F.lds + KI0 + stQ1) = kreg[1];
            *(LAS v4u*)(F.lds + stV) = vreg;
            if (F.tid < 64) *(LAS f32x4*)(F.lds + stD) = dreg;
            if (n + 1 < 32) GLA_LOAD(n + 1);
            if (n > 0) { *(v2u*)optr = ost[0]; *(v2u*)(optr + 16) = ost[1]; }
            __syncthreads();
            s16x8 qiB[4], kiA[IB + 1][4], kvA[4], kvB[4], tA[4][2], vA[(IB >> 1) + 1][2];
#pragma unroll
            for (int s4 = 0; s4 < 4; ++s4) qiB[s4] = *(const LAS s16x8*)(F.lds + QI0 + 4096 * IB + ab[s4]);
            if (n + 1 < 32) {
#pragma unroll
                for (int s4 = 0; s4 < 4; ++s4) {
                    kvA[s4] = cat8(tr_rd(F.lds + KI0 + 4096 * s4 + kaA0), tr_rd(F.lds + KI0 + 4096 * s4 + kaA1));
                    kvB[s4] = cat8(tr_rd(F.lds + 2048 * s4 + vbB0), tr_rd(F.lds + 2048 * s4 + vbB1)); }
            }
#pragma unroll
            for (int jt = 0; jt <= IB; ++jt)
#pragma unroll
                for (int s4 = 0; s4 < 4; ++s4) kiA[jt][s4] = *(const LAS s16x8*)(F.lds + KI0 + 4096 * jt + ab[s4]);
            __builtin_amdgcn_sched_barrier(0);
            f32x16 kv;
#pragma unroll
            for (int r = 0; r < 16; ++r) kv[r] = 0.f;
            f32x4 P[4];
#pragma unroll
            for (int jt = 0; jt < 4; ++jt) P[jt] = (f32x4){0.f, 0.f, 0.f, 0.f};
            if (n + 1 < 32) {
#pragma unroll
                for (int s4 = 0; s4 < 4; ++s4) kv = MFMA32(kvA[s4], kvB[s4], kv);
            }
#pragma unroll
            for (int jt = 0; jt <= IB; ++jt) {
#pragma unroll
                for (int s4 = 0; s4 < 4; ++s4) P[jt] = __builtin_amdgcn_mfma_f32_16x16x32_bf16(kiA[jt][s4], qiB[s4], P[jt], 0, 0, 0);
                if (jt == IB) {
#pragma unroll
                    for (int r = 0; r < 4; ++r) { const int jl = 4 * q + r; const bool keep = dir ? (jl < l15) : (jl <= l15); P[jt][r] = keep ? P[jt][r] : 0.f; } }
            }
            __builtin_amdgcn_sched_barrier(0);
#pragma unroll
            for (int s4 = 0; s4 < 4; ++s4)
#pragma unroll
                for (int mt = 0; mt < 2; ++mt) tA[s4][mt] = *(const LAS s16x8*)(F.lds + 4096 * mt + abT[s4]);
#pragma unroll
            for (int a = 0; a <= (IB >> 1); ++a)
#pragma unroll
                for (int mt = 0; mt < 2; ++mt) vA[a][mt] = cat8(tr_rd(F.lds + 4096 * a + vaA[mt]), tr_rd(F.lds + 4096 * a + 2048 + vaA[mt]));
            __builtin_amdgcn_sched_barrier(0);
            f32x4 oacc[2];
#pragma unroll
            for (int mt = 0; mt < 2; ++mt) oacc[mt] = (f32x4){0.f, 0.f, 0.f, 0.f};
#pragma unroll
            for (int s4 = 0; s4 < 4; ++s4)
#pragma unroll
                for (int mt = 0; mt < 2; ++mt) oacc[mt] = __builtin_amdgcn_mfma_f32_16x16x32_bf16(tA[s4][mt], qiB[s4], oacc[mt], 0, 0, 0);
#pragma unroll
            for (int a = 0; a <= (IB >> 1); ++a) {
                const s16x8 pb = pack8(P[2 * a][0], P[2 * a][1], P[2 * a][2], P[2 * a][3], P[2 * a + 1][0], P[2 * a + 1][1], P[2 * a + 1][2], P[2 * a + 1][3]);
#pragma unroll
                for (int mt = 0; mt < 2; ++mt) oacc[mt] = __builtin_amdgcn_mfma_f32_16x16x32_bf16(vA[a][mt], pb, oacc[mt], 0, 0, 0); }
            if (n + 1 < 32) {
#pragma unroll
                for (int g = 0; g < 4; ++g) { const f32x4 el = *(const LAS f32x4*)(F.lds + 32 * g + dlA), er = *(const LAS f32x4*)(F.lds + 512 + 32 * g + dlA);
#pragma unroll
                    for (int j = 0; j < 4; ++j) T[4 * g + j] = (T[4 * g + j] + kv[4 * g + j]) * (el[j] * er[j]);
                    v2u wv; wv.x = pg8::cvt_pk_bf16(T[4 * g], T[4 * g + 1]); wv.y = pg8::cvt_pk_bf16(T[4 * g + 2], T[4 * g + 3]);
                    *(LAS v2u*)(F.lds + tpub[g]) = wv; }
            }
            optr = O + (size_t)GLA_TOK(n, 16 * IB + l15) * 1024 + h * 256 + dvs * 64 + 32 * u + 4 * q;
#pragma unroll
            for (int mt = 0; mt < 2; ++mt) { ost[mt].x = pg8::cvt_pk_bf16(oacc[mt][0], oacc[mt][1]); ost[mt].y = pg8::cvt_pk_bf16(oacc[mt][2], oacc[mt][3]); }
#pragma unroll
            for (int s4 = 0; s4 < 4; ++s4) { ab[s4] ^= 0x4000u; abT[s4] ^= 0x4000u; tpub[s4] ^= 0x4000u; }
            kaA0 ^= 0x4000u; kaA1 ^= 0x4000u; vbB0 ^= 0x2000u; vbB1 ^= 0x2000u; vaA[0] ^= 0x2000u; vaA[1] ^= 0x2000u;
            stQ0 ^= 0x4000u; stQ1 ^= 0x4000u; stV ^= 0x2000u; stD ^= 0x400u; dlA ^= 0x400u;
        }
        *(v2u*)optr = ost[0]; *(v2u*)(optr + 16) = ost[1];
#undef GLA_TOK
#undef GLA_LOAD
        __syncthreads();
    }
}
__device__ __forceinline__ void gla_scan(const Frame& F) {
    const int w = F.wave, ib = (w < 4) ? (w >> 1) : 3 - ((w - 4) >> 1);
    if (ib == 0) gla_scan_ib<0>(F); else if (ib == 1) gla_scan_ib<1>(F); else if (ib == 2) gla_scan_ib<2>(F); else gla_scan_ib<3>(F);
}

__device__ __forceinline__ void gla_finalize(const Frame& F, int l) {
    const bf16* Of = (const bf16*)(F.ws + WS_OF); const bf16* Ob = (const bf16*)(F.ws + WS_OB); bf16* R = (bf16*)(F.ws + WS_R);
    const float* gg = F_gla_g + l * 1024;
    const int gw = F.vcu * NWAVES + F.wave, NGW = F.G * NWAVES;
    for (int tok = gw; tok < MTOK; tok += NGW) {
        const size_t off = (size_t)tok * 1024 + 16 * F.lane;
        float o[16]; float ss = 0.f;
#pragma unroll
        for (int h = 0; h < 2; ++h) { const v4u a = *(const v4u*)(Of + off + 8 * h), c = *(const v4u*)(Ob + off + 8 * h);
            o[8 * h + 0] = bflo(a.x) + bflo(c.x); o[8 * h + 1] = bfhi(a.x) + bfhi(c.x); o[8 * h + 2] = bflo(a.y) + bflo(c.y); o[8 * h + 3] = bfhi(a.y) + bfhi(c.y);
            o[8 * h + 4] = bflo(a.z) + bflo(c.z); o[8 * h + 5] = bfhi(a.z) + bfhi(c.z); o[8 * h + 6] = bflo(a.w) + bflo(c.w); o[8 * h + 7] = bfhi(a.w) + bfhi(c.w); }
#pragma unroll
        for (int j = 0; j < 16; ++j) ss += o[j] * o[j];
        ss += __shfl_xor(ss, 1); ss += __shfl_xor(ss, 2); ss += __shfl_xor(ss, 4); ss += __shfl_xor(ss, 8);
        const float rs = rsqrtf(ss * (1.f / 256.f) + EPS);
#pragma unroll
        for (int h = 0; h < 2; ++h) { const v4u rr = *(const v4u*)(R + off + 8 * h); const f32x4 g0 = *(const f32x4*)(gg + 16 * F.lane + 8 * h), g1 = *(const f32x4*)(gg + 16 * F.lane + 8 * h + 4);
            v4u w;
            w.x = pk2(o[8 * h + 0] * rs * g0[0] * bflo(rr.x), o[8 * h + 1] * rs * g0[1] * bfhi(rr.x)); w.y = pk2(o[8 * h + 2] * rs * g0[2] * bflo(rr.y), o[8 * h + 3] * rs * g0[3] * bfhi(rr.y));
            w.z = pk2(o[8 * h + 4] * rs * g1[0] * bflo(rr.z), o[8 * h + 5] * rs * g1[1] * bfhi(rr.z)); w.w = pk2(o[8 * h + 6] * rs * g1[2] * bflo(rr.w), o[8 * h + 7] * rs * g1[3] * bfhi(rr.w));
            *(v4u*)(R + off + 8 * h) = w; }
    }
}

__device__ __forceinline__ void final_norm(const Frame& F) {
    const float* ssq = (const float*)(F.ws + WS_SSQ);
    const int gw = F.vcu * NWAVES + F.wave, NGW = F.G * NWAVES;
    for (int row = gw; row < MTOK; row += NGW) { const f32x4 p = *(const f32x4*)(ssq + (size_t)row * 4); const float rs = rsqrtf(((p[0] + p[1]) + (p[2] + p[3])) * (1.f / 1024.f) + EPS);
#pragma unroll
        for (int j = 0; j < 4; ++j) { const int k = 4 * F.lane + 256 * j; float* p4 = F.ka->out + (size_t)row * 1024 + k; const f32x4 xv = *(const f32x4*)p4; const f32x4 g = *(const f32x4*)(F_final_g + k);
            *(f32x4*)p4 = xv * rs * g; } }
}

constexpr int N_PRO = 3, PH_PER_LAYER = 5, N_PHASES = N_PRO + DEPTH * PH_PER_LAYER + 1;

__global__ void __launch_bounds__(NTHR, 2) mk_fwd(Args args) {
    extern __shared__ __attribute__((aligned(16))) unsigned char lds[];
    LAS unsigned char* const L = (LAS unsigned char*)lds;
    volatile LAS unsigned* MISC = (volatile LAS unsigned*)(L + MISC_OFF);
    if (threadIdx.x < 32) MISC[threadIdx.x] = 0u;
    __syncthreads();
    const int lo = args.ph_lo, hi = args.ph_hi;
    XcdBarrier bar; bar.bar = (unsigned*)(args.ws + WS_CTL) + CW_BAR; bar.x = 0; bar.st = nullptr;
    if (hi - lo > 1) bar = xcd_barrier_post((unsigned*)(args.ws + WS_CTL) + CW_BAR, MISC + 8);
#define IN(k) (lo <= (k) && (k) < hi)
#define SEAM(k) do { if (IN(k) && IN((k) + 1)) xcd_barrier(bar); } while (0)

    if (IN(0)) { const Frame F = make_frame(L); phase_p0(F); } SEAM(0);
    if (IN(1)) {
        { const Frame F = make_frame(L);
          pg8::Gemm g{(const bf16*)(F.ws + WS_WFT), nullptr, (const bf16*)(F.ws + WS_TR), 256, 256, 256, 4};
          pg8::WcOrder S{F.G, (int)blockIdx.x}; EpiStore E{(bf16*)(F.ws + WS_WCT), 256};
          pg8::gemm_phase<EpiStore, pg8::WcOrder, true>(F.lds, F.tid, g, S, E); }
        { const Frame F = make_frame(L); phase_p1(F); }
    } SEAM(1);
    if (IN(2)) {
        { const Frame F = make_frame(L);
          pg8::Gemm g{(const bf16*)(F.ws + WS_WCT), nullptr, (const bf16*)(F.ws + WS_WU), 256, 256, 1024, 4};
          pg8::FoldOrder S{F.G, (int)blockIdx.x}; EpiStore E{(bf16*)(F.ws + WS_WTIN), 1024};
          pg8::gemm_phase<EpiStore, pg8::FoldOrder, true>(F.lds, F.tid, g, S, E); }
        { const Frame F = make_frame(L); phase_p2(F); }
    } SEAM(2);

    for (int l = 0; l < DEPTH; ++l) {
        const int pb = N_PRO + l * PH_PER_LAYER;
        if (IN(pb + 0)) {
            const bool gate_first = ((blockIdx.x >> 3) & 1) != 0;
            if (gate_first) { const Frame F = make_frame(L); gate_rows(F, l); }
            { const Frame F = make_frame(L);
              const float* sw = (const float*)(F.ws + WS_SW) + (size_t)l * 8 * NSW;
              pg8::Gemm g{(const bf16*)F.ws, nullptr, (const bf16*)F.ws, 1024, 1024, 1024, 16};
              pg8::InOrder S; S.init(F.G, (int)blockIdx.x, (unsigned)(WS_WTIN + (size_t)l * NPJ * 1024 * 2), (unsigned)WS_XG);
              EpiIn E{EpiAB{(const float*)(F.ws + WS_SSQ), sw, (bf16*)(F.ws + WS_AB)}, EpiProj{(const float*)(F.ws + WS_SSQ), sw, F.ws}};
              if (F.G == 256) pg8::gemm_phase<EpiIn, pg8::InOrder, true>(F.lds, F.tid, g, S, E); }
            if (!gate_first) { const Frame F = make_frame(L); gate_rows(F, l); }
        }
        SEAM(pb + 0);
        if (IN(pb + 1)) {
            const Frame F = make_frame(L);
            fourier_ct(F);
            { const Frame F2 = make_frame(L); gla_prep(F2, l); }
        }
        SEAM(pb + 1);
        if (IN(pb + 2)) { const Frame F = make_frame(L); gla_scan(F); }
        SEAM(pb + 2);
        if (IN(pb + 3)) { const Frame F = make_frame(L); gla_finalize(F, l); }
        SEAM(pb + 3);
        if (IN(pb + 4)) {
            const Frame F = make_frame(L);
            const float* mod = (const float*)(F.ws + WS_MOD);
            pg8::Gemm g{(const bf16*)(F.ws + WS_ZF), (const bf16*)(F.ws + WS_R), (const bf16*)(F.ws + WS_WTOUT) + (size_t)l * 1024 * 2048, 2048, 1024, 2048, 16};
            pg8::StaticOrder S; S.init(MTOK, 1024, F.G, (int)blockIdx.x);
            EpiOut E{l == 0 ? F_x : (const float*)F.ka->out, F.ka->out, (bf16*)(F.ws + WS_XG), (float*)(F.ws + WS_SSQ), mod + (size_t)l * 8 * 3072 + 2048,
                     l + 1 < DEPTH ? (const float*)(F.ws + WS_GMOD) + (size_t)(l + 1) * 8 * 1024 : nullptr};
            if (F.G == 256) pg8::gemm_phase<EpiOut, pg8::StaticOrder, false>(F.lds, F.tid, g, S, E);
        }
        SEAM(pb + 4);
    }
    if (IN(N_PHASES - 1)) { const Frame F = make_frame(L); final_norm(F); }
#undef IN
#undef SEAM
}

extern "C" void kernel_launch(void* const* d_in, const int* in_sizes, int n_in, void* d_out, int out_size, void* d_ws, size_t ws_size, hipStream_t stream) {
    static int grid = 0;
    if (grid == 0) {
        if (n_in != 14 || out_size != MTOK * D || ws_size < WS_END) { fprintf(stderr, "kernel_launch: unexpected problem (n_in %d, out %d, ws %zu < %zu)\n", n_in, out_size, ws_size, (size_t)WS_END); grid = -1; return; }
        int dev = 0, cus = 0;
        if (hipGetDevice(&dev) != hipSuccess || hipDeviceGetAttribute(&cus, hipDeviceAttributeMultiprocessorCount, dev) != hipSuccess) { grid = -1; return; }
        if (hipFuncSetAttribute((const void*)mk_fwd, hipFuncAttributeMaxDynamicSharedMemorySize, LDS_BYTES) != hipSuccess) { fprintf(stderr, "kernel_launch: hipFuncSetAttribute failed\n"); grid = -1; return; }
        (void)hipGetLastError();
        grid = cus;
        if (grid != 256) fprintf(stderr, "kernel_launch: %d CUs; built for 256\n", grid);
    }
    if (grid < 0) return;
    (void)hipMemsetAsync((char*)d_ws + WS_CTL, 0, CTL_ZERO_BYTES, stream);
    Args a{};
    for (int i = 0; i < 14; ++i) a.in[i] = (const float*)d_in[i];
    a.out = (float*)d_out; a.ws = (unsigned char*)d_ws;
#if MK_PER_PHASE
    for (int p = 0; p < N_PHASES; ++p) { a.ph_lo = p; a.ph_hi = p + 1; hipLaunchKernelGGL(mk_fwd, dim3(grid), dim3(NTHR), LDS_BYTES, stream, a); }
#else
    a.ph_lo = 0; a.ph_hi = N_PHASES; hipLaunchKernelGGL(mk_fwd, dim3(grid), dim3(NTHR), LDS_BYTES, stream, a);
#endif
}
```
